# Optimizing an MI355X kernel written in HIP

```python
import math
import jax, jax.numpy as jnp
from jax import lax
import numpy as np


D_MODEL = 1024
BATCH = 4
SEQ = 4096
DEPTH = 4
DEC_BATCH = 8
DEC_SEQ = 2048
PAST_LEN = 128

N_MEM = 256
GRID_W = 64
EPS = 1e-6
HY_WIDTH = 512
HY_SHORT = 3
HY_EMB = 33
HY_FH = 64
HY_SIN_FREQ = 1.0
HY_TARGET = 1e-2
HY_FAST = 0.3
HY_SLOW = 1.5
HY_SHIFT = 0.0
RET_HEADS = 4
RET_DK = 128
RET_DV = 128
RET_WIDTH = RET_HEADS * RET_DV
RET_CHUNK = 128
RET_THETA = 10000.0
ATT_HEADS = 4
ATT_KV_HEADS = 2
ATT_HD = 128
ATT_WIDTH = ATT_HEADS * ATT_HD
ATT_BLOCK = 128
ROPE_THETA = 10000.0
X_HEADS = 4
X_HD = D_MODEL // X_HEADS
D_FF = 4 * D_MODEL
N_BRANCH = 3
MIX_WIDTH = HY_WIDTH + RET_WIDTH + ATT_WIDTH
IN_SPLITS = (3 * HY_WIDTH, RET_HEADS * RET_DK, RET_HEADS * RET_DK, RET_WIDTH, RET_WIDTH, ATT_WIDTH, ATT_KV_HEADS * ATT_HD, ATT_KV_HEADS * ATT_HD, N_BRANCH * D_MODEL)
IN_COLS = sum(IN_SPLITS)

kernel_name = 'hybrid_hyena_retnet_gqa_encoder'


def _split_points(sizes):
    pts, acc = [], 0
    for s in sizes[:-1]:
        acc += s
        pts.append(acc)
    return pts


def rmsnorm(x, g):
    xf = x.astype(jnp.float32)
    y = xf * lax.rsqrt(jnp.mean(xf * xf, axis=-1, keepdims=True) + EPS)
    return (y * g.astype(jnp.float32)).astype(x.dtype)


def rotary_tables(pos, dim, theta):
    inv = theta ** (-jnp.arange(0, dim, 2, dtype=jnp.float32) / dim)
    ang = pos.astype(jnp.float32)[:, None] * inv[None, :]
    return jnp.cos(ang), jnp.sin(ang)


def apply_rotary(x, cos, sin):
    half = x.shape[-1] // 2
    c = cos[None, :, None, :].astype(x.dtype)
    s = sin[None, :, None, :].astype(x.dtype)
    x1, x2 = x[..., :half], x[..., half:]
    return jnp.concatenate([x1 * c - x2 * s, x1 * s + x2 * c], axis=-1)


def short_conv(u, w):
    L = u.shape[1]
    pad = HY_SHORT // 2
    up = jnp.pad(u, ((0, 0), (pad, pad), (0, 0)))
    out = up[:, 0:L] * w[0]
    for j in range(1, HY_SHORT):
        out = out + up[:, j:j + L] * w[j]
    return out


def hyena_spectrum(L, w1, b1, w2, b2, w3):
    f32 = jnp.float32
    t = jnp.linspace(0.0, 1.0, L, dtype=f32)[:, None]
    bands = (HY_EMB - 1) // 2
    w = 2.0 * math.pi * jnp.arange(L, dtype=f32)[:, None] / L
    f = jnp.linspace(1e-4, bands - 1, bands, dtype=f32)[None, :]
    z = jnp.concatenate([t, jnp.cos(f * w), -jnp.sin(f * w)], axis=-1)
    hdn = jnp.sin(HY_SIN_FREQ * (z @ w1.astype(f32) + b1.astype(f32)))
    hdn = jnp.sin(HY_SIN_FREQ * (hdn @ w2.astype(f32) + b2.astype(f32)))
    filt = (hdn @ w3.astype(f32)).reshape(L, 2, HY_WIDTH)
    min_decay = math.log(HY_TARGET) / HY_SLOW
    max_decay = math.log(HY_TARGET) / HY_FAST
    deltas = jnp.abs(jnp.linspace(min_decay, max_decay, HY_WIDTH, dtype=f32))
    mod = jnp.exp(-t * deltas[None, :]) + HY_SHIFT
    filt = filt * mod[:, None, :]
    k_fwd, k_bwd = filt[:, 0], filt[:, 1]
    kfull = jnp.concatenate([k_fwd, jnp.zeros((1, HY_WIDTH), f32), jnp.flip(k_bwd[1:], axis=0)], axis=0)
    return jnp.fft.rfft(kfull, axis=0)


def hyena_mixer(hy_in, conv_w, K, bias):
    u = short_conv(hy_in, conv_w)
    x0, x1, v = jnp.split(u, 3, axis=-1)
    L = u.shape[1]
    zf = (v * x1).astype(jnp.float32)
    Z = jnp.fft.rfft(zf, n=2 * L, axis=1)
    y = jnp.fft.irfft(Z * K[None], n=2 * L, axis=1)[:, :L] + zf * bias.astype(jnp.float32)
    return y.astype(x0.dtype) * x0


def retention_dir(q, k, v, log_gamma, strict):
    B, L, H, dk = q.shape
    dv = v.shape[-1]
    C = RET_CHUNK
    N = L // C
    qc = q.reshape(B, N, C, H, dk)
    kc = k.reshape(B, N, C, H, dk)
    vc = v.reshape(B, N, C, H, dv)
    idx = jnp.arange(C, dtype=jnp.float32)
    diff = idx[:, None] - idx[None, :]
    mask = diff > 0 if strict else diff >= 0
    dmat = jnp.where(mask[None], jnp.exp(jnp.maximum(diff, 0.0)[None] * log_gamma[:, None, None]), 0.0)
    scores = jnp.einsum('bnihd,bnjhd->bnhij', qc, kc) * dmat[None, None]
    intra = jnp.einsum('bnhij,bnjhe->bnihe', scores, vc)
    k_w = jnp.exp((C - 1 - idx)[:, None] * log_gamma[None, :])
    chunk_kv = jnp.einsum('bnjhd,jh,bnjhe->bnhde', kc, k_w, vc)
    chunk_decay = jnp.exp(C * log_gamma)[None, :, None, None]

    def step(S, kv):
        return S * chunk_decay + kv, S

    _, S_prev = lax.scan(step, jnp.zeros((B, H, dk, dv), jnp.float32), jnp.moveaxis(chunk_kv, 1, 0))
    S_prev = jnp.moveaxis(S_prev, 0, 1)
    q_w = jnp.exp((idx + 1.0)[:, None] * log_gamma[None, :])
    inter = jnp.einsum('bnihd,ih,bnhde->bnihe', qc, q_w, S_prev)
    return (intra + inter).reshape(B, L, H, dv)


def retention_mixer(rq, rk, rv, rg, decay_logit, cos, sin):
    B, L, _ = rq.shape
    q = apply_rotary(rq.reshape(B, L, RET_HEADS, RET_DK), cos, sin).astype(jnp.float32)
    k = apply_rotary(rk.reshape(B, L, RET_HEADS, RET_DK), cos, sin).astype(jnp.float32) * (RET_DK ** -0.5)
    v = rv.reshape(B, L, RET_HEADS, RET_DV).astype(jnp.float32)
    lg = jax.nn.log_sigmoid(decay_logit.astype(jnp.float32))
    fwd = retention_dir(q, k, v, lg[0], strict=False)
    bwd = jnp.flip(retention_dir(jnp.flip(q, 1), jnp.flip(k, 1), jnp.flip(v, 1), lg[1], strict=True), 1)
    o = fwd + bwd
    mu = jnp.mean(o, axis=-1, keepdims=True)
    oc = o - mu
    o = oc * lax.rsqrt(jnp.mean(oc * oc, axis=-1, keepdims=True) + EPS)
    o = o.reshape(B, L, RET_WIDTH).astype(rg.dtype)
    return jax.nn.silu(rg) * o


def axial_rotary(x, rc, rs, cc, cs):
    half = x.shape[-1] // 2
    return jnp.concatenate([apply_rotary(x[..., :half], rc, rs), apply_rotary(x[..., half:], cc, cs)], axis=-1)


def block_attention(q, k, v):
    B, L, H, hd = q.shape
    G = H // ATT_KV_HEADS
    nb = L // ATT_BLOCK
    qb = q.reshape(B, nb, ATT_BLOCK, ATT_KV_HEADS, G, hd).transpose(1, 0, 2, 3, 4, 5)
    scale = hd ** -0.5

    def one(qblk):
        s = jnp.einsum('bqkgd,bskd->bkgqs', qblk, k).astype(jnp.float32) * scale
        p = jax.nn.softmax(s, axis=-1).astype(v.dtype)
        return jnp.einsum('bkgqs,bskd->bqkgd', p, v)

    out = lax.map(one, qb)
    return out.transpose(1, 0, 2, 3, 4, 5).reshape(B, L, H * hd)


def attention_mixer(aq, ak, av, qn, kn, rc, rs, cc, cs):
    B, L, _ = aq.shape
    q = rmsnorm(aq.reshape(B, L, ATT_HEADS, ATT_HD), qn)
    k = rmsnorm(ak.reshape(B, L, ATT_KV_HEADS, ATT_HD), kn)
    v = av.reshape(B, L, ATT_KV_HEADS, ATT_HD)
    q = axial_rotary(q, rc, rs, cc, cs)
    k = axial_rotary(k, rc, rs, cc, cs)
    return block_attention(q, k, v)


def cross_attention(h, m, wq, wkv, wo):
    B, L, _ = h.shape
    M = m.shape[1]
    q = (h @ wq).reshape(B, L, X_HEADS, X_HD)
    kk, vv = jnp.split(m @ wkv, 2, axis=-1)
    kk = kk.reshape(B, M, X_HEADS, X_HD)
    vv = vv.reshape(B, M, X_HEADS, X_HD)
    s = jnp.einsum('blhd,bmhd->bhlm', q, kk).astype(jnp.float32) * (X_HD ** -0.5)
    p = jax.nn.softmax(s, axis=-1).astype(vv.dtype)
    o = jnp.einsum('bhlm,bmhd->blhd', p, vv).reshape(B, L, D_MODEL)
    return o @ wo


def trunk(x, mem, g_mix_pre, g_mix_post, w_in, hy_conv, hy_fw1, hy_fb1, hy_fw2, hy_fb2, hy_fw3, hy_bias,
          ret_decay, att_qnorm, att_knorm, w_branch, w_out, g_x_pre, g_x_post, g_mem, w_xq, w_xkv, w_xo,
          g_ff_pre, g_ff_post, w_ff1, w_ff2):
    B, L, _ = x.shape
    rows = L // GRID_W
    pos = jnp.arange(L)
    row_ids = jnp.repeat(jnp.arange(rows), GRID_W)
    col_ids = jnp.tile(jnp.arange(GRID_W), rows)
    ret_cos, ret_sin = rotary_tables(pos, RET_DK, RET_THETA)
    rc, rs = rotary_tables(row_ids, ATT_HD // 2, ROPE_THETA)
    cc, cs = rotary_tables(col_ids, ATT_HD // 2, ROPE_THETA)
    split_pts = _split_points(IN_SPLITS)
    for l in range(DEPTH):
        h = rmsnorm(x, g_mix_pre[l])
        proj = h @ w_in[l]
        hy_in, rq, rk, rv, rg, aq, ak, av, gates = jnp.split(proj, split_pts, axis=-1)
        K = hyena_spectrum(L, hy_fw1[l], hy_fb1[l], hy_fw2[l], hy_fb2[l], hy_fw3[l])
        y_h = hyena_mixer(hy_in, hy_conv[l], K, hy_bias[l])
        y_r = retention_mixer(rq, rk, rv, rg, ret_decay[l], ret_cos, ret_sin)
        y_a = attention_mixer(aq, ak, av, att_qnorm[l], att_knorm[l], rc, rs, cc, cs)
        wb = w_branch[l]
        p_h = y_h @ wb[:HY_WIDTH]
        p_r = y_r @ wb[HY_WIDTH:HY_WIDTH + RET_WIDTH]
        p_a = y_a @ wb[HY_WIDTH + RET_WIDTH:]
        g = jax.nn.sigmoid(gates.reshape(B, L, N_BRANCH, D_MODEL))
        merged = g[:, :, 0] * p_h + g[:, :, 1] * p_r + g[:, :, 2] * p_a
        x = x + rmsnorm(merged @ w_out[l], g_mix_post[l])
        h = rmsnorm(x, g_x_pre[l])
        m = rmsnorm(mem, g_mem[l])
        x = x + rmsnorm(cross_attention(h, m, w_xq[l], w_xkv[l], w_xo[l]), g_x_post[l])
        h = rmsnorm(x, g_ff_pre[l])
        u = jnp.square(jax.nn.relu(h @ w_ff1[l]))
        x = x + rmsnorm(u @ w_ff2[l], g_ff_post[l])
    return x


def setup_inputs(seed: int = 0) -> dict:
    key = jax.random.key(seed)
    ks = iter(jax.random.split(key, 40))

    def nrm(shape, scale):
        return jax.random.normal(next(ks), shape, jnp.float32) * scale

    def gain(shape):
        return 1.0 + nrm(shape, 0.01)

    base = 1.0 - 2.0 ** (-5.0 - jnp.arange(RET_HEADS, dtype=jnp.float32))
    logit = jnp.log(base / (1.0 - base))
    d = {}
    d['x_prompt'] = nrm((BATCH, SEQ, D_MODEL), 1.0)
    d['x_sample'] = nrm((DEC_BATCH, DEC_SEQ, D_MODEL), 1.0)
    d['mem_prompt'] = nrm((BATCH, N_MEM, D_MODEL), 1.0)
    d['mem_sample'] = nrm((DEC_BATCH, N_MEM, D_MODEL), 1.0)
    d['g_mix_pre'] = gain((DEPTH, D_MODEL))
    d['g_mix_post'] = gain((DEPTH, D_MODEL))
    d['w_in'] = nrm((DEPTH, D_MODEL, IN_COLS), D_MODEL ** -0.5)
    d['hy_conv'] = nrm((DEPTH, HY_SHORT, 3 * HY_WIDTH), HY_SHORT ** -0.5)
    d['hy_fw1'] = nrm((DEPTH, HY_EMB, HY_FH), HY_EMB ** -0.5)
    d['hy_fb1'] = nrm((DEPTH, HY_FH), 0.02)
    d['hy_fw2'] = nrm((DEPTH, HY_FH, HY_FH), HY_FH ** -0.5)
    d['hy_fb2'] = nrm((DEPTH, HY_FH), 0.02)
    d['hy_fw3'] = nrm((DEPTH, HY_FH, 2 * HY_WIDTH), 0.02)
    d['hy_bias'] = nrm((DEPTH, HY_WIDTH), 1.0)
    d['ret_decay'] = logit[None, None, :] + nrm((DEPTH, 2, RET_HEADS), 0.1)
    d['att_qnorm'] = gain((DEPTH, ATT_HD))
    d['att_knorm'] = gain((DEPTH, ATT_HD))
    d['w_branch'] = nrm((DEPTH, MIX_WIDTH, D_MODEL), HY_WIDTH ** -0.5)
    d['w_out'] = nrm((DEPTH, D_MODEL, D_MODEL), D_MODEL ** -0.5)
    d['g_x_pre'] = gain((DEPTH, D_MODEL))
    d['g_x_post'] = gain((DEPTH, D_MODEL))
    d['g_mem'] = gain((DEPTH, D_MODEL))
    d['w_xq'] = nrm((DEPTH, D_MODEL, D_MODEL), D_MODEL ** -0.5)
    d['w_xkv'] = nrm((DEPTH, D_MODEL, 2 * D_MODEL), D_MODEL ** -0.5)
    d['w_xo'] = nrm((DEPTH, D_MODEL, D_MODEL), D_MODEL ** -0.5)
    d['g_ff_pre'] = gain((DEPTH, D_MODEL))
    d['g_ff_post'] = gain((DEPTH, D_MODEL))
    d['w_ff1'] = nrm((DEPTH, D_MODEL, D_FF), D_MODEL ** -0.5)
    d['w_ff2'] = nrm((DEPTH, D_FF, D_MODEL), D_FF ** -0.5)
    return d


def reference(x_prompt, x_sample, mem_prompt, mem_sample, g_mix_pre, g_mix_post, w_in, hy_conv, hy_fw1, hy_fb1,
              hy_fw2, hy_fb2, hy_fw3, hy_bias, ret_decay, att_qnorm, att_knorm, w_branch, w_out, g_x_pre, g_x_post,
              g_mem, w_xq, w_xkv, w_xo, g_ff_pre, g_ff_post, w_ff1, w_ff2):
    y_prompt = trunk(x_prompt, mem_prompt, g_mix_pre, g_mix_post, w_in, hy_conv, hy_fw1, hy_fb1, hy_fw2, hy_fb2,
                     hy_fw3, hy_bias, ret_decay, att_qnorm, att_knorm, w_branch, w_out, g_x_pre, g_x_post, g_mem,
                     w_xq, w_xkv, w_xo, g_ff_pre, g_ff_post, w_ff1, w_ff2)
    y_sample = trunk(x_sample, mem_sample, g_mix_pre, g_mix_post, w_in, hy_conv, hy_fw1, hy_fb1, hy_fw2, hy_fb2,
                     hy_fw3, hy_bias, ret_decay, att_qnorm, att_knorm, w_branch, w_out, g_x_pre, g_x_post, g_mem,
                     w_xq, w_xkv, w_xo, g_ff_pre, g_ff_post, w_ff1, w_ff2)
    return (y_prompt, y_sample)
```

```cpp
#include <hip/hip_runtime.h>
#include <hip/hip_cooperative_groups.h>
#include <cstdio>
#include <cstdint>
namespace cg = cooperative_groups;

#define LAS __attribute__((address_space(3)))
#define DI __device__ __forceinline__
typedef unsigned short bf16_t;
typedef short bf16x8 __attribute__((ext_vector_type(8)));
typedef short s16x4 __attribute__((ext_vector_type(4)));
typedef float f32x4 __attribute__((ext_vector_type(4)));
typedef float f32x2 __attribute__((ext_vector_type(2)));
typedef float f32x8 __attribute__((ext_vector_type(8)));
typedef float f32x16 __attribute__((ext_vector_type(16)));
typedef unsigned u32x4 __attribute__((ext_vector_type(4)));
typedef unsigned u32x2 __attribute__((ext_vector_type(2)));

constexpr int D = 1024, TT = 32768, HT = 16384, DEPTH = 4, DFF = 4096;
constexpr int PC = 8192;
constexpr int C_X0 = 0, C_X1 = 512, C_V = 1024, C_RQ = 1536, C_RK = 2048, C_RV = 2560, C_RG = 3072, C_AQ = 3584, C_AK = 4096, C_AV = 4352, C_G = 4608, C_YH = 7680;
constexpr int INC = 7680;
constexpr float EPS = 1e-6f;

constexpr size_t MiB = 1u << 20;
constexpr size_t WS_RTC = 1 * MiB, WS_RTS = 2 * MiB, WS_AXC = 3 * MiB, WS_AXS = 3 * MiB + 65536;
constexpr int FRS0 = 8192 + 64, FRS1 = 4096 + 64;
constexpr size_t WS_FR0 = 4 * MiB, WS_FR1 = WS_FR0 + (size_t)512 * FRS0 * 2;
constexpr size_t WS_WB = 17 * MiB;
constexpr size_t WB_IN = 0, WB_BR = WB_IN + (size_t)INC * 1024 * 2, WB_OUT = WB_BR + (size_t)3 * 1024 * 512 * 2, WB_XQ = WB_OUT + (size_t)1024 * 1024 * 2,
                 WB_XKV = WB_XQ + (size_t)1024 * 1024 * 2, WB_XO = WB_XKV + (size_t)2048 * 1024 * 2, WB_F1 = WB_XO + (size_t)1024 * 1024 * 2, WB_F2 = WB_F1 + (size_t)4096 * 1024 * 2,
                 WB_END = WB_F2 + (size_t)4096 * 1024 * 2;
static_assert(WB_END == 44 * MiB, "wb");
constexpr size_t WS_XN = 61 * MiB, WS_R = 125 * MiB, WS_BIG = 189 * MiB;
constexpr size_t WS_PROJ = WS_BIG, WS_ZT = WS_BIG + 256 * MiB, WS_X0T = WS_ZT + 16 * MiB, WS_FRO0 = WS_X0T + 16 * MiB, WS_FRO1 = WS_FRO0 + (size_t)512 * FRS0 * 2, WS_END = WS_FRO1 + (size_t)512 * FRS1 * 2;
constexpr size_t WS_QX = WS_BIG, WS_P = WS_BIG + 64 * MiB, WS_OX = WS_BIG + 128 * MiB, WS_MN = WS_BIG + 192 * MiB, WS_KK = WS_MN + 6 * MiB, WS_VVT = WS_KK + 6 * MiB;
constexpr size_t WS_U = WS_BIG;
constexpr size_t WS_KV = WS_R;

constexpr int LDS_BYTES = 147456;
constexpr int LDS_X = 131072;
constexpr int LDS_ST = 147456 - 64;

typedef __bf16 bf16x2_t __attribute__((ext_vector_type(2)));
DI unsigned cvt_pk_bf16(float lo, float hi) { const f32x2 v = {lo, hi}; return __builtin_bit_cast(unsigned, __builtin_convertvector(v, bf16x2_t)); }
DI bf16_t f2bf(float f) { return __builtin_bit_cast(bf16_t, (__bf16)f); }
DI float bf2f(bf16_t v) { return __uint_as_float(((unsigned)v) << 16); }
DI float bflo(unsigned w) { return __uint_as_float(w << 16); }
DI float bfhi(unsigned w) { return __uint_as_float(w & 0xffff0000u); }
DI float wave_sum(float v) {
#pragma unroll
    for (int o = 1; o < 64; o <<= 1) v += __shfl_xor(v, o);
    return v;
}
DI float sigmoidf_(float x) { return __builtin_amdgcn_rcpf(1.f + __builtin_amdgcn_exp2f(-1.4426950408889634f * x)); }
#define LDS_WAIT() asm volatile("s_waitcnt lgkmcnt(0)" ::: "memory")
DI void unpack8g(const u32x4 w, float (&f)[8]) { f[0] = bflo(w.x); f[1] = bfhi(w.x); f[2] = bflo(w.y); f[3] = bfhi(w.y); f[4] = bflo(w.z); f[5] = bfhi(w.z); f[6] = bflo(w.w); f[7] = bfhi(w.w); }
DI int opaque_tid(int wave) { int t = wave * 64 + (int)__builtin_amdgcn_mbcnt_hi(~0u, __builtin_amdgcn_mbcnt_lo(~0u, 0u)); asm volatile("" : "+v"(t)); return t; }

namespace pg8 {
constexpr int BM = 256, BK = 64, HALF = 128, HTB = HALF * BK * 2, STAGE_BYTES = 8 * HTB, NXCD = 8, WGM = 8;
__host__ __device__ __forceinline__ int lds_byte(int r, int c) { const int st = (r >> 4) * 2 + (c >> 5), rr = r & 15, cc = c & 31, ob = rr * 64 + cc * 2; return st * 1024 + (ob ^ (((ob >> 9) & 1) << 5)); }
__host__ __device__ __forceinline__ void stage_rc(int b, int& R, int& C) { const int st = b / 1024, sb = b % 1024, swz = sb ^ (((sb >> 9) & 1) << 5); R = (st >> 1) * 16 + swz / 64; C = (st & 1) * 32 + (swz % 64) / 2; }
__host__ __device__ __forceinline__ int perm32(int rho) { const int n = rho >> 4, i = rho & 15; return 8 * (i >> 2) + 4 * n + (i & 3); }

struct Unit { const char* A; const char* B; int pm, pn, z; };
struct GemmP { int lda, ldb, K; };

DI void tile_order(int nM, int nN, int L, int& pm, int& pn) {
    const int nwg = nM * nN; int wgid = L;
    { const int q = nwg / NXCD, r = nwg % NXCD, xcd = wgid % NXCD, off = wgid / NXCD; wgid = (xcd < r ? xcd * (q + 1) : r * (q + 1) + (xcd - r) * q) + off; }
    const int nig = WGM * nN, gid = wgid / nig, fm = gid * WGM, gsz = (nM - fm) < WGM ? (nM - fm) : WGM;
    pm = fm + ((wgid % nig) % gsz); pn = (wgid % nig) / gsz;
}

template <class F> struct EpiRows {
    F f;
    DI void operator()(f32x4 (&acc)[2][2][4][2], const Unit& u, int wr, int wc, int fr, int fq, LAS unsigned char*) const {
        asm volatile("" : "+v"(fr), "+v"(fq));
#pragma unroll
        for (int ai = 0; ai < 2; ++ai)
#pragma unroll
            for (int m = 0; m < 4; ++m) { const int r = ai * HALF + wr * 64 + m * 16 + fr;
#pragma unroll
                for (int bj = 0; bj < 2; ++bj) { const int c = bj * HALF + wc * 32 + 8 * fq; f(u, r, c, acc[ai][bj][m][0], acc[ai][bj][m][1]); } }
    }
};
DI u32x4 pack8(f32x4 a, f32x4 b) { u32x4 w; w.x = cvt_pk_bf16(a[0], a[1]); w.y = cvt_pk_bf16(a[2], a[3]); w.z = cvt_pk_bf16(b[0], b[1]); w.w = cvt_pk_bf16(b[2], b[3]); return w; }

struct EpiSoftmax {
    bf16_t* O; int ldc;
    DI void operator()(f32x4 (&acc)[2][2][4][2], const Unit& u, int wr, int wc, int fr, int fq, LAS unsigned char* lx) const {
        asm volatile("" : "+v"(fr), "+v"(fq));
        LAS f32x2* X = (LAS f32x2*)lx;
#pragma unroll
        for (int ai = 0; ai < 2; ++ai)
#pragma unroll
            for (int m = 0; m < 4; ++m) {
                float mx = -3.0e38f;
#pragma unroll
                for (int bj = 0; bj < 2; ++bj)
#pragma unroll
                    for (int n = 0; n < 2; ++n) { const f32x4 x = acc[ai][bj][m][n]; mx = fmaxf(mx, fmaxf(fmaxf(x[0], x[1]), fmaxf(x[2], x[3]))); }
                mx = fmaxf(mx, __shfl_xor(mx, 16)); mx = fmaxf(mx, __shfl_xor(mx, 32));
                float s = 0.f;
#pragma unroll
                for (int bj = 0; bj < 2; ++bj)
#pragma unroll
                    for (int n = 0; n < 2; ++n) { f32x4 x = acc[ai][bj][m][n];
#pragma unroll
                        for (int e = 0; e < 4; ++e) { x[e] = __expf(x[e] - mx); s += x[e]; }
                        acc[ai][bj][m][n] = x; }
                s += __shfl_xor(s, 16); s += __shfl_xor(s, 32);
                if (fq == 0) X[(ai * HALF + wr * 64 + m * 16 + fr) * 4 + wc] = (f32x2){mx, s};
                __builtin_amdgcn_sched_barrier(0);
            }
        LDS_WAIT(); __builtin_amdgcn_s_barrier(); asm volatile("" ::: "memory");
#pragma unroll
        for (int ai = 0; ai < 2; ++ai)
#pragma unroll
            for (int m = 0; m < 4; ++m) {
                const int r = ai * HALF + wr * 64 + m * 16 + fr;
                const f32x2 a = X[r * 4 + 0], b = X[r * 4 + 1], c = X[r * 4 + 2], d = X[r * 4 + 3];
                const float M = fmaxf(fmaxf(a.x, b.x), fmaxf(c.x, d.x));
                const float S = a.y * __expf(a.x - M) + b.y * __expf(b.x - M) + c.y * __expf(c.x - M) + d.y * __expf(d.x - M);
                const float fac = __expf(X[r * 4 + wc].x - M) / S;
                bf16_t* rowp = O + (size_t)(u.pm * BM + r) * ldc + u.z * 256 + wc * 32 + 8 * fq;
#pragma unroll
                for (int bj = 0; bj < 2; ++bj) *(u32x4*)(rowp + bj * HALF) = pack8(acc[ai][bj][m][0] * fac, acc[ai][bj][m][1] * fac);
                __builtin_amdgcn_sched_barrier(0);
            }
        LDS_WAIT(); __builtin_amdgcn_s_barrier(); asm volatile("" ::: "memory");
    }
};

template <class Epi, class Sched>
DI void gemm_phase(int wave_, LAS unsigned char* lds, LAS unsigned char* lx, const GemmP g, const Sched& S, const Epi& E) {
    const int tid = opaque_tid(wave_), wid = __builtin_amdgcn_readfirstlane(tid >> 6), lane = tid & 63, wr = wid >> 2, wc = wid & 3, fr = lane & 15, fq = lane >> 4;
    const int K = g.K, nt = K / BK;
    unsigned voffA[2], voffB[2];
#pragma unroll
    for (int i = 0; i < 2; ++i) { int R, C; stage_rc(tid * 16 + i * 8192, R, C); const int Rb = (R & ~31) + perm32(R & 31);
        voffA[i] = (unsigned)(R * g.lda + C) * 2u; voffB[i] = (unsigned)(Rb * g.ldb + C) * 2u; }
    const size_t kstep = (size_t)(BK * 2);
    const size_t hstepA = (size_t)HALF * g.lda * 2, hstepB = (size_t)HALF * g.ldb * 2;
    const unsigned ldsw = (unsigned)wid * 1024u;
    const int aoff = lds_byte(wr * 64 + fr, fq * 8), boff = lds_byte(wc * 32 + fr, fq * 8);
#define PG8_SA(b, h) (((b) * 2 + (h)) * HTB)
#define PG8_SB(b, h) ((4 + (b) * 2 + (h)) * HTB)
#define PG8_STAGE(bufoff, gbase, voff) do { _Pragma("unroll") for (int _i = 0; _i < 2; ++_i) \
        __builtin_amdgcn_global_load_lds((const unsigned*)((const char*)(gbase) + (voff)[_i]), (LAS unsigned*)(lds + (bufoff) + ldsw + _i * 8192), 16, 0, 0); } while (0)
#define PG8_LDA(dst, b, h) do { _Pragma("unroll") for (int m = 0; m < 4; ++m) _Pragma("unroll") for (int k = 0; k < 2; ++k) dst[m][k] = *(const LAS bf16x8*)(lds + PG8_SA(b, h) + aoff + m * 2048 + k * 1024); } while (0)
#define PG8_LDB(dst, b, h) do { _Pragma("unroll") for (int n = 0; n < 2; ++n) _Pragma("unroll") for (int k = 0; k < 2; ++k) dst[n][k] = *(const LAS bf16x8*)(lds + PG8_SB(b, h) + boff + n * 2048 + k * 1024); } while (0)
#define PG8_MMA(ai, bj, At, Bt) do { __builtin_amdgcn_s_setprio(1); _Pragma("unroll") for (int m = 0; m < 4; ++m) _Pragma("unroll") for (int n = 0; n < 2; ++n) _Pragma("unroll") for (int k = 0; k < 2; ++k) \
        acc[ai][bj][m][n] = __builtin_amdgcn_mfma_f32_16x16x32_bf16(Bt[n][k], At[m][k], acc[ai][bj][m][n], 0, 0, 0); __builtin_amdgcn_s_setprio(0); } while (0)
#define PG8_WAIT_V(n) asm volatile("s_waitcnt vmcnt(" #n ")" ::: "memory")
#define PG8_WAIT_L(n) asm volatile("s_waitcnt lgkmcnt(" #n ")" ::: "memory")
#define PG8_BAR __builtin_amdgcn_s_barrier()
#define PG8_SCHED __builtin_amdgcn_sched_barrier(0)
    Unit cur, nxt; int ui = 0;
    if (!S.next(0, cur)) return;
    f32x4 acc[2][2][4][2];
#pragma unroll
    for (int a = 0; a < 2; ++a)
#pragma unroll
        for (int b = 0; b < 2; ++b)
#pragma unroll
            for (int m = 0; m < 4; ++m)
#pragma unroll
                for (int n = 0; n < 2; ++n) acc[a][b][m][n] = (f32x4){0.f, 0.f, 0.f, 0.f};
    bf16x8 At[4][2], B0[2][2], B1[2][2];
    const char* cA = cur.A; const char* cB = cur.B;
    PG8_STAGE(PG8_SB(0, 0), cB, voffB); PG8_STAGE(PG8_SB(0, 1), cB + hstepB, voffB); PG8_STAGE(PG8_SA(0, 0), cA, voffA); PG8_STAGE(PG8_SA(0, 1), cA + hstepA, voffA);
    if (wr == 1) PG8_BAR;
    PG8_WAIT_V(2); PG8_BAR;
    PG8_STAGE(PG8_SB(1, 0), cB + kstep, voffB); PG8_STAGE(PG8_SA(1, 0), cA + kstep, voffA); PG8_STAGE(PG8_SB(1, 1), cB + hstepB + kstep, voffB);
    PG8_WAIT_V(6); PG8_BAR;
    for (;;) {
        const bool has_next = S.next(ui + 1, nxt);
        const char* nA = has_next ? nxt.A : cA; const char* nB = has_next ? nxt.B : cB;
#pragma unroll 1
        for (int t = 0; t < nt; t += 2) {
            const bool last = (t == nt - 2);
            const char* a1 = cA + (size_t)(t + 1) * kstep;
            const char* a2 = last ? nA : cA + (size_t)(t + 2) * kstep; const char* b2 = last ? nB : cB + (size_t)(t + 2) * kstep;
            const char* a3 = a2 + kstep; const char* b3 = b2 + kstep;
            PG8_LDB(B0, 0, 0); PG8_LDB(B1, 0, 1); PG8_SCHED; PG8_LDA(At, 0, 0); PG8_STAGE(PG8_SA(1, 1), a1 + hstepA, voffA);
            PG8_WAIT_V(8); PG8_WAIT_L(0); PG8_BAR; PG8_MMA(0, 0, At, B0); PG8_MMA(0, 1, At, B1); PG8_BAR; PG8_SCHED;
            PG8_LDA(At, 0, 1); PG8_STAGE(PG8_SB(0, 0), b2, voffB); PG8_STAGE(PG8_SB(0, 1), b2 + hstepB, voffB); PG8_STAGE(PG8_SA(0, 0), a2, voffA);
            PG8_WAIT_V(8); PG8_WAIT_L(0); PG8_BAR; PG8_MMA(1, 0, At, B0); PG8_MMA(1, 1, At, B1); PG8_BAR; PG8_SCHED;
            PG8_LDB(B0, 1, 0); PG8_LDB(B1, 1, 1); PG8_SCHED; PG8_LDA(At, 1, 0); PG8_STAGE(PG8_SA(0, 1), a2 + hstepA, voffA);
            PG8_WAIT_V(8); PG8_WAIT_L(0); PG8_BAR; PG8_MMA(0, 0, At, B0); PG8_MMA(0, 1, At, B1); PG8_BAR; PG8_SCHED;
            PG8_LDA(At, 1, 1); PG8_STAGE(PG8_SB(1, 0), b3, voffB); PG8_STAGE(PG8_SB(1, 1), b3 + hstepB, voffB); PG8_STAGE(PG8_SA(1, 0), a3, voffA);
            PG8_WAIT_V(8); PG8_WAIT_L(0); PG8_BAR; PG8_MMA(1, 0, At, B0); PG8_MMA(1, 1, At, B1); PG8_BAR; PG8_SCHED;
        }
        if (wr == 0) PG8_BAR;
        E(acc, cur, wr, wc, fr, fq, lx);
        if (!has_next) break;
#pragma unroll
        for (int a = 0; a < 2; ++a)
#pragma unroll
            for (int b = 0; b < 2; ++b)
#pragma unroll
                for (int m = 0; m < 4; ++m)
#pragma unroll
                    for (int n = 0; n < 2; ++n) acc[a][b][m][n] = (f32x4){0.f, 0.f, 0.f, 0.f};
        cur = nxt; cA = nA; cB = nB; ++ui;
        if (wr == 1) PG8_BAR;
    }
    PG8_WAIT_V(0);
    PG8_BAR;
#undef PG8_SA
#undef PG8_SB
#undef PG8_STAGE
#undef PG8_LDA
#undef PG8_LDB
#undef PG8_MMA
#undef PG8_WAIT_V
#undef PG8_WAIT_L
#undef PG8_BAR
#undef PG8_SCHED
}
}
using pg8::Unit; using pg8::GemmP; using pg8::pack8;

namespace attn {
constexpr int AD = 128, NW = 8, QBLK = 32, KVBLK = 64, LD = PC;
constexpr float SCALE = 0.088388347648318440f;
constexpr float THR = 8.f;
constexpr size_t SHM_V = KVBLK * AD * 2, SHM_K = KVBLK * AD * 2, SHM_ATTN = 2 * SHM_V + 2 * SHM_K + NW * 64 * 4;
#define KSWZ(row, colB) ((row) * 256 + ((colB) ^ (((row) & 7) << 4)))
#define SBAR() __builtin_amdgcn_sched_barrier(0)
DI int crow(int r, int hi) { return (r & 3) + 8 * (r >> 2) + 4 * hi; }
DI void partialSM(f32x16& p0, f32x16& p1, float& m_reg, float& mn, float& alpha) {
  constexpr float C = SCALE * 1.4426950408889634f;
  float pmax = p0[0]; for (int r = 1; r < 16; ++r) pmax = fmaxf(pmax, p0[r]); for (int r = 0; r < 16; ++r) pmax = fmaxf(pmax, p1[r]);
  { auto rr = __builtin_amdgcn_permlane32_swap(__float_as_uint(pmax), __float_as_uint(pmax), false, false);
    pmax = fmaxf(__uint_as_float(rr[0]), __uint_as_float(rr[1])); }
  if (__builtin_expect(__all(pmax - m_reg <= THR / SCALE), 1)) { mn = m_reg; alpha = 1.f; }
  else { mn = fmaxf(m_reg, pmax); alpha = __builtin_amdgcn_exp2f((m_reg - mn) * C); m_reg = mn; }
  float mnC = -mn * C;
  for (int r = 0; r < 16; ++r) p0[r] = fmaf(p0[r], C, mnC); for (int r = 0; r < 16; ++r) p1[r] = fmaf(p1[r], C, mnC);
  for (int r = 0; r < 16; ++r) p0[r] = __builtin_amdgcn_exp2f(p0[r]);
}
DI void finishSM(f32x16& p0, f32x16& p1, float alpha, float& l_reg, bf16x8& pa0, bf16x8& pa1, bf16x8& pa2, bf16x8& pa3) {
  for (int r = 0; r < 16; ++r) p1[r] = __builtin_amdgcn_exp2f(p1[r]);
  float ps = 0; for (int r = 0; r < 16; ++r) ps += p0[r]; for (int r = 0; r < 16; ++r) ps += p1[r];
  { auto rr = __builtin_amdgcn_permlane32_swap(__float_as_uint(ps), __float_as_uint(ps), false, false);
    ps = __uint_as_float(rr[0]) + __uint_as_float(rr[1]); }
  l_reg = l_reg * alpha + ps;
#define PK4(P, BASE, OUT) do { unsigned a0 = cvt_pk_bf16(P[BASE + 0], P[BASE + 1]), a1 = cvt_pk_bf16(P[BASE + 2], P[BASE + 3]);   \
    unsigned b0 = cvt_pk_bf16(P[BASE + 4], P[BASE + 5]), b1 = cvt_pk_bf16(P[BASE + 6], P[BASE + 7]);                              \
    auto r0 = __builtin_amdgcn_permlane32_swap(a0, b0, false, false); auto r1 = __builtin_amdgcn_permlane32_swap(a1, b1, false, false); \
    u32x4 w = {r0[0], r1[0], r0[1], r1[1]}; OUT = *reinterpret_cast<bf16x8*>(&w); } while (0)
  PK4(p0, 0, pa0); PK4(p0, 8, pa1); PK4(p1, 0, pa2); PK4(p1, 8, pa3);
#undef PK4
}
DI void qkt(f32x16& p0, f32x16& p1, const bf16_t* Ks, const bf16x8* qr, int r32, int hi) {
  p0 = f32x16{}; p1 = f32x16{};
  for (int d0 = 0; d0 < 8; ++d0) { int cb = (d0 * 16 + hi * 8) * 2;
    bf16x8 b0 = *reinterpret_cast<const bf16x8*>((const char*)Ks + KSWZ(r32, cb));
    bf16x8 b1 = *reinterpret_cast<const bf16x8*>((const char*)Ks + KSWZ(32 + r32, cb));
    p0 = __builtin_amdgcn_mfma_f32_32x32x16_bf16(b0, qr[d0], p0, 0, 0, 0);
    p1 = __builtin_amdgcn_mfma_f32_32x32x16_bf16(b1, qr[d0], p1, 0, 0, 0); }
}
DI int v_st(int k, int c) { const int kk = (k & ~0xC) | ((k & 4) << 1) | ((k & 8) >> 1); return ((kk >> 3) * 4 + (c >> 5)) * 512 + ((kk & 7) * 32 + (c & 31)) * 2; }
DI int v_rd_base(int lane) { return ((lane & 3) << 3) | (((lane >> 2) & 3) << 6) | (((lane >> 4) & 1) << 5) | (((lane >> 5) & 1) << 8); }
constexpr int v_rd_off(int d0, int ks, int half) { return d0 * 512 + ks * 4096 + half * 2048; }
template <int OFF> DI s16x4 tr_read(int vb) {
  s16x4 r; asm volatile("ds_read_b64_tr_b16 %0, %1 offset:%2" : "=&v"(r) : "v"(vb), "i"(OFF) : "memory"); return r;
}
template <int D0> DI void pv_one(f32x16& od, int vb, bf16x8 pa0, bf16x8 pa1, bf16x8 pa2, bf16x8 pa3) {
  const s16x4 l0 = tr_read<v_rd_off(D0, 0, 0)>(vb), h0 = tr_read<v_rd_off(D0, 0, 1)>(vb), l1 = tr_read<v_rd_off(D0, 1, 0)>(vb), h1 = tr_read<v_rd_off(D0, 1, 1)>(vb);
  const s16x4 l2 = tr_read<v_rd_off(D0, 2, 0)>(vb), h2 = tr_read<v_rd_off(D0, 2, 1)>(vb), l3 = tr_read<v_rd_off(D0, 3, 0)>(vb), h3 = tr_read<v_rd_off(D0, 3, 1)>(vb);
  asm volatile("s_waitcnt lgkmcnt(0)" ::: "memory"); SBAR();
#define PK(L, H) (bf16x8){L[0], L[1], L[2], L[3], H[0], H[1], H[2], H[3]}
  od = __builtin_amdgcn_mfma_f32_32x32x16_bf16(pa0, PK(l0, h0), od, 0, 0, 0);
  od = __builtin_amdgcn_mfma_f32_32x32x16_bf16(pa1, PK(l1, h1), od, 0, 0, 0);
  od = __builtin_amdgcn_mfma_f32_32x32x16_bf16(pa2, PK(l2, h2), od, 0, 0, 0);
  od = __builtin_amdgcn_mfma_f32_32x32x16_bf16(pa3, PK(l3, h3), od, 0, 0, 0);
#undef PK
}
DI void pv_d0(f32x16* o, int vb, bf16x8 pa0, bf16x8 pa1, bf16x8 pa2, bf16x8 pa3) {
  pv_one<0>(o[0], vb, pa0, pa1, pa2, pa3); pv_one<1>(o[1], vb, pa0, pa1, pa2, pa3); pv_one<2>(o[2], vb, pa0, pa1, pa2, pa3); pv_one<3>(o[3], vb, pa0, pa1, pa2, pa3);
}
DI void attn_dense_body(int wave_, const bf16_t* __restrict__ Qb, const bf16_t* __restrict__ Kh, const bf16_t* __restrict__ Vh, bf16_t* Ob, int seq, char* lds) {
  const int tid = opaque_tid(wave_), wid = tid >> 6, lane = tid & 63, r32 = lane & 31, hi = lane >> 5;
  bf16_t* V_lds = (bf16_t*)lds; bf16_t* K_lds = (bf16_t*)(lds + 2 * SHM_V);
  float* ws = (float*)(lds + 2 * SHM_V + 2 * SHM_K) + wid * 64; float* li_l = ws; float* al_l = ws + 32;
  float m_reg = -1e30f, l_reg = 0; f32x16 o[4] = {}; bf16x8 qr[8];
  const bf16_t* Qw = Qb + (long)(wid * QBLK + r32) * LD + hi * 8;
#pragma unroll
  for (int d0 = 0; d0 < 8; ++d0) qr[d0] = *reinterpret_cast<const bf16x8*>(Qw + d0 * 16);
  const int sr = tid >> 4, sc = (tid & 15) * 8, vst0 = v_st(sr, sc), vst1 = v_st(32 + sr, sc);
  const int vb0 = (int)(uintptr_t)V_lds + v_rd_base(lane);
  struct { bf16x8 vs0, vs1, ks0, ks1; } sr_[2];
#define SLOAD(i, k0) do { sr_[i].vs0 = *(const bf16x8*)(&Vh[(long)((k0) + sr) * LD + sc]); sr_[i].vs1 = *(const bf16x8*)(&Vh[(long)((k0) + 32 + sr) * LD + sc]); \
    sr_[i].ks0 = *(const bf16x8*)(&Kh[(long)((k0) + sr) * LD + sc]); sr_[i].ks1 = *(const bf16x8*)(&Kh[(long)((k0) + 32 + sr) * LD + sc]); } while (0)
#define SWRITE(b, i) do { *(bf16x8*)((char*)V_lds + (b) * SHM_V + vst0) = sr_[i].vs0;          \
    *(bf16x8*)((char*)V_lds + (b) * SHM_V + vst1) = sr_[i].vs1; int kc = sc * 2;               \
    *(bf16x8*)((char*)K_lds + (b) * SHM_K + KSWZ(sr, kc)) = sr_[i].ks0;                       \
    *(bf16x8*)((char*)K_lds + (b) * SHM_K + KSWZ(32 + sr, kc)) = sr_[i].ks1; } while (0)
#define SWAIT() asm volatile("s_waitcnt vmcnt(4)" ::: "memory")
#define RESC(a) do { if (__any((a) < 1.f)) { if (hi == 0) al_l[r32] = (a); asm volatile("s_waitcnt lgkmcnt(0)" ::: "memory"); \
    for (int d = 0; d < 4; ++d) for (int r = 0; r < 16; ++r) o[d][r] *= al_l[crow(r, hi)]; } } while (0)
  f32x16 pA0, pA1, pB0, pB1; float mnA, mnB, alA, alB; bf16x8 pa0, pa1, pa2, pa3; const int NT = seq / KVBLK;
  constexpr int SE = 0, SO = 1;
  SLOAD(SE, 0); asm volatile("s_waitcnt vmcnt(0)" ::: "memory"); SWRITE(0, SE); __syncthreads();
  qkt(pA0, pA1, K_lds, qr, r32, hi); partialSM(pA0, pA1, m_reg, mnA, alA);
  SLOAD(SO, KVBLK); if (2 < NT) SLOAD(SE, 2 * KVBLK);
  SWAIT(); SWRITE(1, SO); __syncthreads();
  for (int j = 1; j + 1 < NT; j += 2) {
    SBAR(); qkt(pB0, pB1, (bf16_t*)((char*)K_lds + SHM_K), qr, r32, hi);
    finishSM(pA0, pA1, alA, l_reg, pa0, pa1, pa2, pa3); SBAR();
    SLOAD(SO, (j + 2) * KVBLK); SBAR();
    pv_d0(o, vb0, pa0, pa1, pa2, pa3); partialSM(pB0, pB1, m_reg, mnB, alB);
    __syncthreads(); SWAIT(); SWRITE(0, SE);
    RESC(alB); __syncthreads();
    SBAR(); qkt(pA0, pA1, K_lds, qr, r32, hi);
    finishSM(pB0, pB1, alB, l_reg, pa0, pa1, pa2, pa3); SBAR();
    if (j + 3 < NT) SLOAD(SE, (j + 3) * KVBLK); SBAR();
    pv_d0(o, vb0 + (int)SHM_V, pa0, pa1, pa2, pa3); partialSM(pA0, pA1, m_reg, mnA, alA);
    __syncthreads(); SWAIT(); SWRITE(1, SO);
    RESC(alA); __syncthreads();
  }
  SBAR(); qkt(pB0, pB1, (bf16_t*)((char*)K_lds + SHM_K), qr, r32, hi);
  finishSM(pA0, pA1, alA, l_reg, pa0, pa1, pa2, pa3); SBAR();
  pv_d0(o, vb0, pa0, pa1, pa2, pa3); partialSM(pB0, pB1, m_reg, mnB, alB);
  __syncthreads(); RESC(alB);
  finishSM(pB0, pB1, alB, l_reg, pa0, pa1, pa2, pa3); SBAR();
  pv_d0(o, vb0 + (int)SHM_V, pa0, pa1, pa2, pa3);
  if (hi == 0) li_l[r32] = l_reg; asm volatile("s_waitcnt lgkmcnt(0)" ::: "memory");
  float rli[16];
#pragma unroll
  for (int r = 0; r < 16; ++r) rli[r] = __builtin_amdgcn_rcpf(li_l[crow(r, hi)]);
  bf16_t* Ow = Ob + (long)(wid * QBLK) * LD;
#pragma unroll
  for (int r = 0; r < 16; ++r) { int orow = crow(r, hi);
    for (int d0 = 0; d0 < 4; ++d0) Ow[(long)orow * LD + d0 * 32 + r32] = f2bf(o[d0][r] * rli[r]); }
  asm volatile("s_waitcnt vmcnt(0) lgkmcnt(0)" ::: "memory"); __syncthreads();
#undef SLOAD
#undef SWRITE
#undef SWAIT
#undef RESC
}
}

struct Inputs {
    const float *x_prompt, *x_sample, *mem_prompt, *mem_sample, *g_mix_pre, *g_mix_post, *w_in, *hy_conv, *hy_fw1, *hy_fb1, *hy_fw2, *hy_fb2, *hy_fw3, *hy_bias,
                *ret_decay, *att_qnorm, *att_knorm, *w_branch, *w_out, *g_x_pre, *g_x_post, *g_mem, *w_xq, *w_xkv, *w_xo, *g_ff_pre, *g_ff_post, *w_ff1, *w_ff2;
};
struct Args { Inputs in; float* out; unsigned char* ws; int ph_lo, ph_hi; };

DI void transpose_item(const float* W, int K, int N, bf16_t* WT, int item, LAS float* scr, int lane) {
    const int nblk = N / 32, kb = item / nblk, nb = item % nblk, k0 = 64 * kb, n0 = 32 * nb;
    float tv[32];
#pragma unroll
    for (int i = 0; i < 32; ++i) { const int kk = 2 * i + (lane >> 5); tv[i] = W[(size_t)(k0 + kk) * N + n0 + (lane & 31)]; }
#pragma unroll
    for (int i = 0; i < 32; ++i) { const int kk = 2 * i + (lane >> 5); scr[kk * 33 + (lane & 31)] = tv[i]; }
    LDS_WAIT();
    const int c = lane & 7;
#pragma unroll
    for (int j = 0; j < 4; ++j) { const int n = (lane >> 3) + 8 * j; const LAS float* s = scr + (8 * c) * 33 + n;
        u32x4 o; o.x = cvt_pk_bf16(s[0 * 33], s[1 * 33]); o.y = cvt_pk_bf16(s[2 * 33], s[3 * 33]); o.z = cvt_pk_bf16(s[4 * 33], s[5 * 33]); o.w = cvt_pk_bf16(s[6 * 33], s[7 * 33]);
        *(u32x4*)(WT + (size_t)(n0 + n) * K + k0 + 8 * c) = o; }
    LDS_WAIT();
}
DI void convert_weights(const Inputs& in, int l, unsigned char* ws, LAS unsigned char* lds, int gw, int NGW, int wave, int lane) {
    LAS float* scr = (LAS float*)(lds + wave * 16384);
    unsigned char* wb = ws + WS_WB;
    constexpr int I_IN = 16 * 240, I_BR = 8 * 32, I_SQ = 16 * 32, I_KV = 16 * 64, I_F1 = 16 * 128, I_F2 = 64 * 32;
    for (int it = gw; it < I_IN; it += NGW) transpose_item(in.w_in + (size_t)l * 1024 * INC, 1024, INC, (bf16_t*)(wb + WB_IN), it, scr, lane);
    for (int it = gw; it < 3 * I_BR; it += NGW) { const int br = it / I_BR; transpose_item(in.w_branch + (size_t)l * 1536 * 1024 + (size_t)br * 512 * 1024, 512, 1024, (bf16_t*)(wb + WB_BR) + (size_t)br * 1024 * 512, it % I_BR, scr, lane); }
    for (int it = gw; it < I_SQ; it += NGW) transpose_item(in.w_out + (size_t)l * 1024 * 1024, 1024, 1024, (bf16_t*)(wb + WB_OUT), it, scr, lane);
    for (int it = gw; it < I_SQ; it += NGW) transpose_item(in.w_xq + (size_t)l * 1024 * 1024, 1024, 1024, (bf16_t*)(wb + WB_XQ), it, scr, lane);
    for (int it = gw; it < I_KV; it += NGW) transpose_item(in.w_xkv + (size_t)l * 1024 * 2048, 1024, 2048, (bf16_t*)(wb + WB_XKV), it, scr, lane);
    for (int it = gw; it < I_SQ; it += NGW) transpose_item(in.w_xo + (size_t)l * 1024 * 1024, 1024, 1024, (bf16_t*)(wb + WB_XO), it, scr, lane);
    for (int it = gw; it < I_F1; it += NGW) transpose_item(in.w_ff1 + (size_t)l * 1024 * 4096, 1024, 4096, (bf16_t*)(wb + WB_F1), it, scr, lane);
    for (int it = gw; it < I_F2; it += NGW) transpose_item(in.w_ff2 + (size_t)l * 4096 * 1024, 4096, 1024, (bf16_t*)(wb + WB_F2), it, scr, lane);
}

template <bool XIN_BF, bool XOUT_BF>
DI void norm_row(const void* xin, const bf16_t* Rrow, const float* gpost, void* xout, const float* gpre, bf16_t* xn, int lane) {
    f32x4 v[4];
#pragma unroll
    for (int j = 0; j < 4; ++j) {
        if (XIN_BF) { const u32x2 w = *(const u32x2*)((const bf16_t*)xin + 4 * lane + 256 * j); v[j] = (f32x4){bflo(w.x), bfhi(w.x), bflo(w.y), bfhi(w.y)}; }
        else v[j] = *(const f32x4*)((const float*)xin + 4 * lane + 256 * j); }
    if (Rrow) {
        f32x4 r[4]; float ss = 0.f;
#pragma unroll
        for (int j = 0; j < 4; ++j) { const u32x2 w = *(const u32x2*)(Rrow + 4 * lane + 256 * j); r[j] = (f32x4){bflo(w.x), bfhi(w.x), bflo(w.y), bfhi(w.y)};
            ss += (r[j][0] * r[j][0] + r[j][1] * r[j][1]) + (r[j][2] * r[j][2] + r[j][3] * r[j][3]); }
        const float rinv = __builtin_amdgcn_rsqf(wave_sum(ss) * (1.f / 1024.f) + EPS);
#pragma unroll
        for (int j = 0; j < 4; ++j) { const f32x4 g = *(const f32x4*)(gpost + 4 * lane + 256 * j); v[j] += r[j] * rinv * g; }
    }
    if (xout) {
#pragma unroll
        for (int j = 0; j < 4; ++j) {
            if (XOUT_BF) { u32x2 w; w.x = cvt_pk_bf16(v[j][0], v[j][1]); w.y = cvt_pk_bf16(v[j][2], v[j][3]); *(u32x2*)((bf16_t*)xout + 4 * lane + 256 * j) = w;
                           v[j] = (f32x4){bflo(w.x), bfhi(w.x), bflo(w.y), bfhi(w.y)}; }
            else *(f32x4*)((float*)xout + 4 * lane + 256 * j) = v[j]; }
    }
    if (xn) {
        float ss = 0.f;
#pragma unroll
        for (int j = 0; j < 4; ++j) ss += (v[j][0] * v[j][0] + v[j][1] * v[j][1]) + (v[j][2] * v[j][2] + v[j][3] * v[j][3]);
        const float rinv = __builtin_amdgcn_rsqf(wave_sum(ss) * (1.f / 1024.f) + EPS);
#pragma unroll
        for (int j = 0; j < 4; ++j) { const f32x4 g = *(const f32x4*)(gpre + 4 * lane + 256 * j); const f32x4 o = v[j] * rinv * g;
            u32x2 w; w.x = cvt_pk_bf16(o[0], o[1]); w.y = cvt_pk_bf16(o[2], o[3]); *(u32x2*)(xn + 4 * lane + 256 * j) = w; }
    }
}

template <bool XOUT_BF, int NR>
DI void norm_rows(const bf16_t* xin, const bf16_t* Rb, const float* gpost, void* xout, const float* gpre, bf16_t* xnb, size_t row0, size_t rstride, int lane) {
    f32x4 v[NR][4], r[NR][4];
#pragma unroll
    for (int q = 0; q < NR; ++q)
#pragma unroll
        for (int j = 0; j < 4; ++j) { const size_t off = (row0 + q * rstride) * D + 4 * lane + 256 * j;
            const u32x2 w = *(const u32x2*)(xin + off); v[q][j] = (f32x4){bflo(w.x), bfhi(w.x), bflo(w.y), bfhi(w.y)};
            const u32x2 w2 = *(const u32x2*)(Rb + off); r[q][j] = (f32x4){bflo(w2.x), bfhi(w2.x), bflo(w2.y), bfhi(w2.y)}; }
    float ss[NR], s2[NR];
#pragma unroll
    for (int q = 0; q < NR; ++q) { ss[q] = 0.f; s2[q] = 0.f;
#pragma unroll
        for (int j = 0; j < 4; ++j) ss[q] += (r[q][j][0] * r[q][j][0] + r[q][j][1] * r[q][j][1]) + (r[q][j][2] * r[q][j][2] + r[q][j][3] * r[q][j][3]); }
#pragma unroll
    for (int o = 1; o < 64; o <<= 1)
#pragma unroll
        for (int q = 0; q < NR; ++q) ss[q] += __shfl_xor(ss[q], o);
#pragma unroll
    for (int q = 0; q < NR; ++q) { const float rinv = __builtin_amdgcn_rsqf(ss[q] * (1.f / 1024.f) + EPS);
#pragma unroll
        for (int j = 0; j < 4; ++j) { const size_t off = (row0 + q * rstride) * D + 4 * lane + 256 * j;
            const f32x4 g = *(const f32x4*)(gpost + 4 * lane + 256 * j); v[q][j] += r[q][j] * rinv * g;
            if (XOUT_BF) { u32x2 w; w.x = cvt_pk_bf16(v[q][j][0], v[q][j][1]); w.y = cvt_pk_bf16(v[q][j][2], v[q][j][3]); *(u32x2*)((bf16_t*)xout + off) = w;
                           v[q][j] = (f32x4){bflo(w.x), bfhi(w.x), bflo(w.y), bfhi(w.y)}; }
            else *(f32x4*)((float*)xout + off) = v[q][j];
            s2[q] += (v[q][j][0] * v[q][j][0] + v[q][j][1] * v[q][j][1]) + (v[q][j][2] * v[q][j][2] + v[q][j][3] * v[q][j][3]); } }
    if (xnb) {
#pragma unroll
        for (int o = 1; o < 64; o <<= 1)
#pragma unroll
            for (int q = 0; q < NR; ++q) s2[q] += __shfl_xor(s2[q], o);
#pragma unroll
        for (int q = 0; q < NR; ++q) { const float rinv = __builtin_amdgcn_rsqf(s2[q] * (1.f / 1024.f) + EPS);
#pragma unroll
            for (int j = 0; j < 4; ++j) { const size_t off = (row0 + q * rstride) * D + 4 * lane + 256 * j;
                const f32x4 g = *(const f32x4*)(gpre + 4 * lane + 256 * j); const f32x4 o = v[q][j] * rinv * g;
                u32x2 w; w.x = cvt_pk_bf16(o[0], o[1]); w.y = cvt_pk_bf16(o[2], o[3]); *(u32x2*)(xnb + off) = w; } }
    }
}

DI void make_tables(unsigned char* ws, int gtid, int NT) {
    float* rtc = (float*)(ws + WS_RTC); float* rts = (float*)(ws + WS_RTS); float* axc = (float*)(ws + WS_AXC); float* axs = (float*)(ws + WS_AXS);
    const double TWO_PI = 6.283185307179586476925286766559;
    for (int i = gtid; i < 4096 * 64 + 64 * 32; i += NT) {
        int pos, fi; double inv;
        if (i < 4096 * 64) { pos = i >> 6; fi = i & 63; inv = exp(-9.210340371976182736 * (double)fi / 64.0); }
        else { const int j = i - 4096 * 64; pos = j >> 5; fi = j & 31; inv = exp(-9.210340371976182736 * (double)fi / 32.0); }
        const double ang = (double)pos * inv; const double red = ang - TWO_PI * rint(ang / TWO_PI);
        const float c = __cosf((float)red), s = __sinf((float)red);
        if (i < 4096 * 64) { rtc[i] = c; rts[i] = s; } else { axc[i - 4096 * 64] = c; axs[i - 4096 * 64] = s; }
    }
}

DI void filter_gen(const Inputs& in, int l, unsigned char* ws, LAS unsigned char* lds, int vcu, int G, int wave, int tid) {
    const float* w1 = in.hy_fw1 + (size_t)l * 33 * 64; const float* b1 = in.hy_fb1 + l * 64; const float* w2 = in.hy_fw2 + (size_t)l * 64 * 64; const float* b2 = in.hy_fb2 + l * 64;
    const float* w3 = in.hy_fw3 + (size_t)l * 64 * 1024;
    const int lane = tid & 63, chunk = vcu & 3, wgi = vcu >> 2, nwg = (G + 3 - chunk) >> 2;
    LAS float* W3s = (LAS float*)lds; LAS float* W1s = (LAS float*)(lds + 65536); LAS float* W2s = (LAS float*)(lds + 65536 + 8448); LAS float* Bs = (LAS float*)(lds + 65536 + 8448 + 16384);
    __syncthreads();
    { f32x4 t3[8];
#pragma unroll
      for (int k = 0; k < 8; ++k) { const int i = tid + 512 * k; t3[k] = *(const f32x4*)(w3 + (i >> 6) * 1024 + 256 * chunk + (i & 63) * 4); }
      f32x4 t2[2], t1[2];
#pragma unroll
      for (int k = 0; k < 2; ++k) { const int i = tid + 512 * k; t2[k] = *(const f32x4*)(w2 + i * 4); t1[k] = i < 528 ? *(const f32x4*)(w1 + i * 4) : (f32x4){0.f, 0.f, 0.f, 0.f}; }
#pragma unroll
      for (int k = 0; k < 8; ++k) { const int i = tid + 512 * k; *(LAS f32x4*)(W3s + (i >> 6) * 256 + (i & 63) * 4) = t3[k]; }
#pragma unroll
      for (int k = 0; k < 2; ++k) { const int i = tid + 512 * k; *(LAS f32x4*)(W2s + i * 4) = t2[k]; if (i < 528) *(LAS f32x4*)(W1s + i * 4) = t1[k]; } }
    if (tid < 64) Bs[tid] = b1[tid]; else if (tid < 128) Bs[tid] = b2[tid - 64];
    __syncthreads();
    for (int it = wgi * 8 + wave; it < 4096 + 2048; it += nwg * 8) {
        const int g = it >= 4096, t = g ? it - 4096 : it, L = g ? 2048 : 4096, FRS = g ? FRS1 : FRS0;
        bf16_t* FR = (bf16_t*)(ws + (g ? WS_FR1 : WS_FR0)); bf16_t* FRO = (bf16_t*)(ws + (g ? WS_FRO1 : WS_FRO0));
        const float tl = (float)t / (float)(L - 1);
        const float w = 6.2831853071795864769f * (float)t / (float)L;
        float z;
        { const int k = lane; const int fi = (k >= 17) ? k - 17 : k - 1; const float f = 1e-4f + (float)fi * ((15.0f - 1e-4f) / 15.0f);
          z = (k == 0) ? tl : (k <= 16 ? __cosf(f * w) : -__sinf(f * w)); if (k > 32) z = 0.f; }
        float a = Bs[lane];
#pragma unroll 11
        for (int k = 0; k < 33; ++k) a += __shfl(z, k) * W1s[k * 64 + lane];
        const float h1 = __sinf(a);
        a = Bs[64 + lane];
#pragma unroll 16
        for (int k = 0; k < 64; ++k) a += __shfl(h1, k) * W2s[k * 64 + lane];
        const float h2 = __sinf(a);
        float o[4] = {0.f, 0.f, 0.f, 0.f};
#pragma unroll 16
        for (int k = 0; k < 64; ++k) { const float hk = __shfl(h2, k);
#pragma unroll
            for (int q = 0; q < 4; ++q) o[q] += hk * W3s[k * 256 + lane + 64 * q]; }
#pragma unroll
        for (int q = 0; q < 4; ++q) {
            const int cidx = 256 * chunk + lane + 64 * q, dir = cidx >> 9, c = cidx & 511;
            const float delta = fabsf(-3.0701134573253942f + (float)c * ((-15.350567286626972f + 3.0701134573253942f) / 511.0f));
            const float val = o[q] * __expf(-tl * delta);
            bf16_t* row = FR + (size_t)c * FRS; bf16_t* rowo = FRO + (size_t)c * FRS;
            if (dir == 0) { row[L - t] = f2bf(val); rowo[L - t - 1] = f2bf(val); }
            else if (t >= 1) { row[L + t] = f2bf(val); rowo[L + t - 1] = f2bf(val); }
        }
    }
    __syncthreads();
}

DI void prep_attn(const Inputs& in, int l, unsigned char* ws, int half, int gw, int NGW, int lane) {
    constexpr int NTK = 4;
    bf16_t* proj = (bf16_t*)(ws + WS_PROJ); const float* axc = (const float*)(ws + WS_AXC); const float* axs = (const float*)(ws + WS_AXS);
    const int L = half ? 2048 : 4096;
    const int d1 = lane < 32 ? lane : 64 + (lane - 32), d2 = d1 + 32, fi = lane & 31;
    const float gq1 = in.att_qnorm[l * 128 + d1], gq2 = in.att_qnorm[l * 128 + d2], gk1 = in.att_knorm[l * 128 + d1], gk2 = in.att_knorm[l * 128 + d2];
    for (int tok0 = gw; tok0 < HT; tok0 += NTK * NGW) {
        float x1[NTK][6], x2[NTK][6], c[NTK], sn[NTK];
#pragma unroll
        for (int k = 0; k < NTK; ++k) { const int tok = tok0 + k * NGW < HT ? tok0 + k * NGW : tok0, t = tok % L; const int pos = lane < 32 ? (t >> 6) : (t & 63);
            c[k] = axc[pos * 32 + fi]; sn[k] = axs[pos * 32 + fi];
            const bf16_t* row = proj + (size_t)tok * PC;
#pragma unroll
            for (int v = 0; v < 6; ++v) { const int base = v < 4 ? C_AQ + 128 * v : C_AK + 128 * (v - 4); x1[k][v] = bf2f(row[base + d1]); x2[k][v] = bf2f(row[base + d2]); } }
        float ss[NTK][6];
#pragma unroll
        for (int k = 0; k < NTK; ++k)
#pragma unroll
            for (int v = 0; v < 6; ++v) ss[k][v] = x1[k][v] * x1[k][v] + x2[k][v] * x2[k][v];
#pragma unroll
        for (int o = 1; o < 64; o <<= 1)
#pragma unroll
            for (int k = 0; k < NTK; ++k)
#pragma unroll
                for (int v = 0; v < 6; ++v) ss[k][v] += __shfl_xor(ss[k][v], o);
#pragma unroll
        for (int k = 0; k < NTK; ++k) { if (tok0 + k * NGW < HT) { bf16_t* row = proj + (size_t)(tok0 + k * NGW) * PC;
#pragma unroll
            for (int v = 0; v < 6; ++v) { const int base = v < 4 ? C_AQ + 128 * v : C_AK + 128 * (v - 4);
                const float rinv = __builtin_amdgcn_rsqf(ss[k][v] * (1.f / 128.f) + EPS);
                const float y1 = x1[k][v] * rinv * (v < 4 ? gq1 : gk1), y2 = x2[k][v] * rinv * (v < 4 ? gq2 : gk2);
                row[base + d1] = f2bf(y1 * c[k] - y2 * sn[k]); row[base + d2] = f2bf(y1 * sn[k] + y2 * c[k]); } } }
    }
}

DI void prep_hyena(const Inputs& in, int l, unsigned char* ws, int half, int vcu, int G, int tid) {
    const bf16_t* proj = (const bf16_t*)(ws + WS_PROJ); bf16_t* ZT = (bf16_t*)(ws + WS_ZT); bf16_t* X0T = (bf16_t*)(ws + WS_X0T);
    const int L = half ? 2048 : 4096, ntb = L / 64;
    const float* cw = in.hy_conv + (size_t)l * 3 * 1536;
    const int cch = tid & 127, tq = tid >> 7, c0 = 4 * cch;
    f32x4 w[3][3];
#pragma unroll
    for (int j = 0; j < 3; ++j)
#pragma unroll
        for (int sg = 0; sg < 3; ++sg) w[j][sg] = *(const f32x4*)(cw + j * 1536 + sg * 512 + c0);
    for (int tile = vcu; tile < HT / 64; tile += G) {
        const int s = tile / ntb, tb = tile % ntb;
        const bf16_t* base = proj + (size_t)(s * L) * PC + c0;
#pragma unroll 1
        for (int hb = 0; hb < 2; ++hb) {
            const int t0 = tb * 64 + (tq + 4 * hb) * 8;
            u32x2 rw[10][3];
#pragma unroll
            for (int r = 0; r < 10; ++r)
#pragma unroll
                for (int sg = 0; sg < 3; ++sg) { const int t = t0 - 1 + r; rw[r][sg] = (u32x2){0u, 0u}; if (t >= 0 && t < L) rw[r][sg] = *(const u32x2*)(base + (size_t)t * PC + sg * 512); }
            unsigned zt[4][4], xt[4][4];
            f32x4 zprev, xprev;
#pragma unroll
            for (int k = 0; k < 8; ++k) {
                f32x4 u[3];
#pragma unroll
                for (int sg = 0; sg < 3; ++sg) { const u32x2 pv = rw[k][sg], cu = rw[k + 1][sg], nx = rw[k + 2][sg];
                    const f32x4 a = {bflo(pv.x), bfhi(pv.x), bflo(pv.y), bfhi(pv.y)}, b = {bflo(cu.x), bfhi(cu.x), bflo(cu.y), bfhi(cu.y)}, c = {bflo(nx.x), bfhi(nx.x), bflo(nx.y), bfhi(nx.y)};
                    u[sg] = a * w[0][sg] + b * w[1][sg] + c * w[2][sg]; }
                const f32x4 z = u[2] * u[1], x = u[0];
                if (k & 1) {
#pragma unroll
                    for (int e = 0; e < 4; ++e) { zt[e][k >> 1] = cvt_pk_bf16(zprev[e], z[e]); xt[e][k >> 1] = cvt_pk_bf16(xprev[e], x[e]); } }
                else { zprev = z; xprev = x; }
            }
#pragma unroll
            for (int e = 0; e < 4; ++e) { const size_t off = (size_t)(s * 512 + c0 + e) * L + t0;
                *(u32x4*)(ZT + off) = (u32x4){zt[e][0], zt[e][1], zt[e][2], zt[e][3]}; *(u32x4*)(X0T + off) = (u32x4){xt[e][0], xt[e][1], xt[e][2], xt[e][3]}; }
        }
    }
}
DI void post_hyena(unsigned char* ws, int half, LAS unsigned char* lds, int vcu, int G, int tid) {
    bf16_t* proj = (bf16_t*)(ws + WS_PROJ); const bf16_t* YT = (const bf16_t*)(ws + WS_X0T);
    const int L = half ? 2048 : 4096, ntb = L / 64;
    LAS bf16_t* Ts = (LAS bf16_t*)lds;
    for (int tile = vcu; tile < (HT / 64) * 8; tile += G) {
        const int cb = tile & 7, tbg = tile >> 3, s = tbg / ntb, tb = tbg % ntb;
        { const int c2 = tid >> 3, ch = tid & 7; *(LAS u32x4*)(Ts + c2 * 72 + 8 * ch) = *(const u32x4*)(YT + (size_t)(s * 512 + cb * 64 + c2) * L + tb * 64 + 8 * ch); }
        __syncthreads();
        { const int t2 = tid >> 3, ch = tid & 7; unsigned short e[8];
#pragma unroll
          for (int k = 0; k < 8; ++k) e[k] = Ts[(8 * ch + k) * 72 + t2];
          u32x4 o; o.x = e[0] | ((unsigned)e[1] << 16); o.y = e[2] | ((unsigned)e[3] << 16); o.z = e[4] | ((unsigned)e[5] << 16); o.w = e[6] | ((unsigned)e[7] << 16);
          *(u32x4*)(proj + (size_t)(s * L + tb * 64 + t2) * PC + C_YH + cb * 64 + 8 * ch) = o; }
        __syncthreads();
    }
}

DI void hyena_unit(const Inputs& in, int l, unsigned char* ws, int half, int c, LAS unsigned char* lds, int tid) {
    const int L = half ? 2048 : 4096, NB = half ? 8 : 4, nblk = L / 32, FRS = half ? FRS1 : FRS0, ZS = L + 2048, ZSP = (ZS / 32) * 40;
    const bf16_t* FR = (const bf16_t*)(ws + (half ? WS_FR1 : WS_FR0)) + (size_t)c * FRS; const bf16_t* FRO = (const bf16_t*)(ws + (half ? WS_FRO1 : WS_FRO0)) + (size_t)c * FRS;
    const bf16_t* ZT = (const bf16_t*)(ws + WS_ZT); bf16_t* XT = (bf16_t*)(ws + WS_X0T);
    constexpr int FRB = 16640;
    LAS unsigned char* Zl = lds + 2 * FRB;
    const int cpr = ZS / 8, nfr = (2 * L + 64) / 8;
    { u32x4 fv[5], zv[8];
#pragma unroll
      for (int k = 0; k < 5; ++k) { const int i = tid + 512 * k, cp = i >= nfr, kk = cp ? i - nfr : i; fv[k] = (u32x4){0u, 0u, 0u, 0u};
          if (i < 2 * nfr && kk < 2 * L / 8) fv[k] = *(const u32x4*)((cp ? FRO : FR) + kk * 8);
          if (cp && kk == 2 * L / 8 - 1) fv[k].w &= 0xffffu; }
#pragma unroll
      for (int k = 0; k < 8; ++k) { const int i = tid + 512 * k, b = i / cpr, j = i % cpr, m = j * 8 - 1024; zv[k] = (u32x4){0u, 0u, 0u, 0u};
          if (i < NB * cpr && m >= 0 && m < L) zv[k] = *(const u32x4*)(ZT + (size_t)(b * 512 + c) * L + m); }
#pragma unroll
      for (int k = 0; k < 5; ++k) { const int i = tid + 512 * k, cp = i >= nfr, kk = cp ? i - nfr : i; if (i < 2 * nfr) *(LAS u32x4*)(lds + cp * FRB + kk * 16) = fv[k]; }
#pragma unroll
      for (int k = 0; k < 8; ++k) { const int i = tid + 512 * k, b = i / cpr, j = i % cpr; if (i < NB * cpr) *(LAS u32x4*)(Zl + ((size_t)b * ZSP + (j >> 2) * 40 + (j & 3) * 8) * 2) = zv[k]; } }
    __syncthreads();
    const int wave = tid >> 6, lane = tid & 63, i32 = lane & 31, g = lane >> 5;
    const int gpb = nblk / 32, a0 = 32 * (wave % gpb), b0 = 2 * (wave / gpb);
    const int dlo = a0 - nblk + 1, dhi = a0 + 31;
    f32x16 acc0 = {}, acc1 = {};
    const LAS unsigned char* Zb = Zl + (size_t)b0 * ZSP * 2;
    const int zstep = ZSP * 2;
    int s0 = L - 32 * dlo - i32 + 8 * g;
    const LAS unsigned char* zp0 = Zb + ((32 + a0 + i32 - dlo) * 40 + 8 * g) * 2;
#define HY_A(jh) ({ const int s_ = s0 + 16 * (jh); const LAS unsigned* p_ = (const LAS unsigned*)(lds + (s_ & 1) * FRB) + (s_ >> 1); \
        u32x4 aw_; aw_.x = p_[0]; aw_.y = p_[1]; aw_.z = p_[2]; aw_.w = p_[3]; __builtin_bit_cast(bf16x8, aw_); })
#define HY_B(gi, jh) (*(const LAS bf16x8*)(zp0 + (gi) * zstep + (jh) * 32))
    for (int d = dlo; d <= dhi; ++d) {
#pragma unroll
        for (int jh = 0; jh < 2; ++jh) { const bf16x8 a = HY_A(jh);
            acc0 = __builtin_amdgcn_mfma_f32_32x32x16_bf16(a, HY_B(0, jh), acc0, 0, 0, 0);
            acc1 = __builtin_amdgcn_mfma_f32_32x32x16_bf16(a, HY_B(1, jh), acc1, 0, 0, 0); }
        s0 -= 32; zp0 -= 80;
    }
#undef HY_A
#undef HY_B
    const float bias = in.hy_bias[l * 512 + c];
    u32x2 xx[2][4];
#pragma unroll
    for (int k = 0; k < 2; ++k)
#pragma unroll
        for (int q = 0; q < 4; ++q) xx[k][q] = *(const u32x2*)(XT + (size_t)((b0 + k) * 512 + c) * L + 32 * (a0 + i32) + 8 * q + 4 * g);
#pragma unroll
    for (int k = 0; k < 2; ++k) {
        const int a = a0 + i32, b = b0 + k;
#pragma unroll
        for (int q = 0; q < 4; ++q) {
            const int t0 = 32 * a + 8 * q + 4 * g;
            const u32x2 zz = *(const LAS u32x2*)(Zb + k * zstep + ((32 + a) * 40 + 8 * q + 4 * g) * 2);
            bf16_t* xp = XT + (size_t)(b * 512 + c) * L + t0;
            const float z0 = bflo(zz.x), z1 = bfhi(zz.x), z2 = bflo(zz.y), z3 = bfhi(zz.y);
            const float x0 = bflo(xx[k][q].x), x1 = bfhi(xx[k][q].x), x2 = bflo(xx[k][q].y), x3 = bfhi(xx[k][q].y);
            const float c0 = k ? acc1[4 * q + 0] : acc0[4 * q + 0], c1 = k ? acc1[4 * q + 1] : acc0[4 * q + 1], c2 = k ? acc1[4 * q + 2] : acc0[4 * q + 2], c3 = k ? acc1[4 * q + 3] : acc0[4 * q + 3];
            u32x2 o; o.x = cvt_pk_bf16((c0 + z0 * bias) * x0, (c1 + z1 * bias) * x1); o.y = cvt_pk_bf16((c2 + z2 * bias) * x2, (c3 + z3 * bias) * x3);
            *(u32x2*)xp = o;
        }
    }
    __syncthreads();
}

namespace ret {
constexpr int TS = 136, TILE_B = 128 * TS * 2;
DI float logsig(float x) { return -log1pf(__expf(-x)); }
DI void unpack8(const u32x4 w, float (&f)[8]) { f[0] = bflo(w.x); f[1] = bfhi(w.x); f[2] = bflo(w.y); f[3] = bfhi(w.y); f[4] = bflo(w.z); f[5] = bfhi(w.z); f[6] = bflo(w.w); f[7] = bfhi(w.w); }
DI int sw(int row, int col) { return row * TS + ((((col >> 3) ^ (row >> 3)) & 15) << 3) + (col & 7); }
DI void rot_item(const bf16_t* src, const float* rtc, const float* rts, int pos0, int j, int d0, float (&o1)[8], float (&o2)[8]) {
    float x1[8], x2[8]; unpack8(*(const u32x4*)(src + (size_t)j * PC + d0), x1); unpack8(*(const u32x4*)(src + (size_t)j * PC + 64 + d0), x2);
    const float* cp = rtc + (size_t)(pos0 + j) * 64 + d0; const float* sp = rts + (size_t)(pos0 + j) * 64 + d0;
    const f32x4 ca = *(const f32x4*)cp, cb = *(const f32x4*)(cp + 4), sa = *(const f32x4*)sp, sb = *(const f32x4*)(sp + 4);
#pragma unroll
    for (int e = 0; e < 8; ++e) { const float c = e < 4 ? ca[e & 3] : cb[e & 3], s = e < 4 ? sa[e & 3] : sb[e & 3]; o1[e] = x1[e] * c - x2[e] * s; o2[e] = x1[e] * s + x2[e] * c; }
}
DI void stage_rot_rm(LAS unsigned char* dst, const bf16_t* src, const float* rtc, const float* rts, int pos0, float scale, int tid) {
    for (int it = tid; it < 1024; it += 512) { const int j = it >> 3, d0 = (it & 7) * 8; float o1[8], o2[8]; rot_item(src, rtc, rts, pos0, j, d0, o1, o2);
        u32x4 w1, w2; w1.x = cvt_pk_bf16(o1[0] * scale, o1[1] * scale); w1.y = cvt_pk_bf16(o1[2] * scale, o1[3] * scale); w1.z = cvt_pk_bf16(o1[4] * scale, o1[5] * scale); w1.w = cvt_pk_bf16(o1[6] * scale, o1[7] * scale);
        w2.x = cvt_pk_bf16(o2[0] * scale, o2[1] * scale); w2.y = cvt_pk_bf16(o2[2] * scale, o2[3] * scale); w2.z = cvt_pk_bf16(o2[4] * scale, o2[5] * scale); w2.w = cvt_pk_bf16(o2[6] * scale, o2[7] * scale);
        *(LAS u32x4*)(dst + sw(j, d0) * 2) = w1; *(LAS u32x4*)(dst + sw(j, 64 + d0) * 2) = w2; }
}
DI void stage_rot_T2(LAS unsigned char* dF, LAS unsigned char* dB, const bf16_t* src, const float* rtc, const float* rts, int pos0, float scale, float lgf, float lgb, int tid) {
    LAS bf16_t* F = (LAS bf16_t*)dF; LAS bf16_t* B = (LAS bf16_t*)dB;
    for (int it = tid; it < 1024; it += 512) { const int j = it >> 3, d0 = (it & 7) * 8; float o1[8], o2[8]; rot_item(src, rtc, rts, pos0, j, d0, o1, o2);
        const float wf = __expf((float)(127 - j) * lgf) * scale, wb = __expf((float)j * lgb) * scale;
#pragma unroll
        for (int e = 0; e < 8; ++e) { const int i1 = sw(d0 + e, j), i2 = sw(64 + d0 + e, j); F[i1] = f2bf(o1[e] * wf); F[i2] = f2bf(o2[e] * wf); B[i1] = f2bf(o1[e] * wb); B[i2] = f2bf(o2[e] * wb); } }
}
struct RotIn { u32x4 a, b; f32x4 ca, cb, sa, sb; };
DI RotIn rot_load(const bf16_t* src, const float* rtc, const float* rts, int pos0, int j, int d0) {
    RotIn r; r.a = *(const u32x4*)(src + (size_t)j * PC + d0); r.b = *(const u32x4*)(src + (size_t)j * PC + 64 + d0);
    const float* cp = rtc + (size_t)(pos0 + j) * 64 + d0; const float* sp = rts + (size_t)(pos0 + j) * 64 + d0;
    r.ca = *(const f32x4*)cp; r.cb = *(const f32x4*)(cp + 4); r.sa = *(const f32x4*)sp; r.sb = *(const f32x4*)(sp + 4); return r;
}
DI void rot_apply(const RotIn& r, float (&o1)[8], float (&o2)[8]) {
    float x1[8], x2[8]; unpack8(r.a, x1); unpack8(r.b, x2);
#pragma unroll
    for (int e = 0; e < 8; ++e) { const float c = e < 4 ? r.ca[e & 3] : r.cb[e & 3], s = e < 4 ? r.sa[e & 3] : r.sb[e & 3]; o1[e] = x1[e] * c - x2[e] * s; o2[e] = x1[e] * s + x2[e] * c; }
}
DI void stage_rot_rm_b(LAS unsigned char* dst, const bf16_t* src, const float* rtc, const float* rts, int pos0, float scale, int tid) {
    const RotIn r0 = rot_load(src, rtc, rts, pos0, tid >> 3, (tid & 7) * 8), r1 = rot_load(src, rtc, rts, pos0, 64 + (tid >> 3), (tid & 7) * 8);
#pragma unroll
    for (int k = 0; k < 2; ++k) { const int j = 64 * k + (tid >> 3), d0 = (tid & 7) * 8; float o1[8], o2[8]; rot_apply(k ? r1 : r0, o1, o2);
        u32x4 w1, w2; w1.x = cvt_pk_bf16(o1[0] * scale, o1[1] * scale); w1.y = cvt_pk_bf16(o1[2] * scale, o1[3] * scale); w1.z = cvt_pk_bf16(o1[4] * scale, o1[5] * scale); w1.w = cvt_pk_bf16(o1[6] * scale, o1[7] * scale);
        w2.x = cvt_pk_bf16(o2[0] * scale, o2[1] * scale); w2.y = cvt_pk_bf16(o2[2] * scale, o2[3] * scale); w2.z = cvt_pk_bf16(o2[4] * scale, o2[5] * scale); w2.w = cvt_pk_bf16(o2[6] * scale, o2[7] * scale);
        *(LAS u32x4*)(dst + sw(j, d0) * 2) = w1; *(LAS u32x4*)(dst + sw(j, 64 + d0) * 2) = w2; }
}
DI void stage_rot_T2_b(LAS unsigned char* dF, LAS unsigned char* dB, const bf16_t* src, const float* rtc, const float* rts, int pos0, float scale, float lgf, float lgb, int tid) {
    LAS bf16_t* F = (LAS bf16_t*)dF; LAS bf16_t* B = (LAS bf16_t*)dB;
    const RotIn r0 = rot_load(src, rtc, rts, pos0, tid >> 3, (tid & 7) * 8), r1 = rot_load(src, rtc, rts, pos0, 64 + (tid >> 3), (tid & 7) * 8);
#pragma unroll
    for (int k = 0; k < 2; ++k) { const int j = 64 * k + (tid >> 3), d0 = (tid & 7) * 8; float o1[8], o2[8]; rot_apply(k ? r1 : r0, o1, o2);
        const float wf = __expf((float)(127 - j) * lgf) * scale, wb = __expf((float)j * lgb) * scale;
#pragma unroll
        for (int e = 0; e < 8; ++e) { const int i1 = sw(d0 + e, j), i2 = sw(64 + d0 + e, j); F[i1] = f2bf(o1[e] * wf); F[i2] = f2bf(o2[e] * wf); B[i1] = f2bf(o1[e] * wb); B[i2] = f2bf(o2[e] * wb); } }
}
DI void stage_T(LAS unsigned char* dst, const bf16_t* src, int tid) {
    LAS bf16_t* T = (LAS bf16_t*)dst;
    for (int it = tid; it < 2048; it += 512) { const int j = it >> 4, c0 = (it & 15) * 8; const u32x4 w = *(const u32x4*)(src + (size_t)j * PC + c0);
        T[sw(c0 + 0, j)] = (bf16_t)(w.x & 0xffff); T[sw(c0 + 1, j)] = (bf16_t)(w.x >> 16); T[sw(c0 + 2, j)] = (bf16_t)(w.y & 0xffff); T[sw(c0 + 3, j)] = (bf16_t)(w.y >> 16);
        T[sw(c0 + 4, j)] = (bf16_t)(w.z & 0xffff); T[sw(c0 + 5, j)] = (bf16_t)(w.z >> 16); T[sw(c0 + 6, j)] = (bf16_t)(w.w & 0xffff); T[sw(c0 + 7, j)] = (bf16_t)(w.w >> 16); }
}
DI void stage_T_b(LAS unsigned char* dst, const bf16_t* src, int tid) {
    LAS bf16_t* T = (LAS bf16_t*)dst;
    u32x4 wv[4];
#pragma unroll
    for (int k = 0; k < 4; ++k) { const int it = tid + 512 * k, j = it >> 4, c0 = (it & 15) * 8; wv[k] = *(const u32x4*)(src + (size_t)j * PC + c0); }
#pragma unroll
    for (int k = 0; k < 4; ++k) { const int it = tid + 512 * k, j = it >> 4, c0 = (it & 15) * 8; const u32x4 w = wv[k];
        T[sw(c0 + 0, j)] = (bf16_t)(w.x & 0xffff); T[sw(c0 + 1, j)] = (bf16_t)(w.x >> 16); T[sw(c0 + 2, j)] = (bf16_t)(w.y & 0xffff); T[sw(c0 + 3, j)] = (bf16_t)(w.y >> 16);
        T[sw(c0 + 4, j)] = (bf16_t)(w.z & 0xffff); T[sw(c0 + 5, j)] = (bf16_t)(w.z >> 16); T[sw(c0 + 6, j)] = (bf16_t)(w.w & 0xffff); T[sw(c0 + 7, j)] = (bf16_t)(w.w >> 16); }
}
DI void stage_state(LAS unsigned char* dst, const bf16_t* src, int tid) {
    u32x4 wv[4];
#pragma unroll
    for (int k = 0; k < 4; ++k) { const int it = tid + 512 * k, e = it >> 4, d0 = (it & 15) * 8; wv[k] = *(const u32x4*)(src + e * 128 + d0); }
#pragma unroll
    for (int k = 0; k < 4; ++k) { const int it = tid + 512 * k, e = it >> 4, d0 = (it & 15) * 8; *(LAS u32x4*)(dst + sw(e, d0) * 2) = wv[k]; }
}
DI void mma16(f32x4 (&acc)[8], const LAS unsigned char* At, int arow0, const LAS unsigned char* Bt, int lane) {
    const int l15 = lane & 15, quad = lane >> 4;
#pragma unroll
    for (int ks = 0; ks < 4; ++ks) {
        const bf16x8 a = *(const LAS bf16x8*)(At + sw(arow0 + l15, 32 * ks + 8 * quad) * 2);
#pragma unroll
        for (int cg = 0; cg < 8; ++cg) { const bf16x8 b = *(const LAS bf16x8*)(Bt + sw(16 * cg + l15, 32 * ks + 8 * quad) * 2);
            acc[cg] = __builtin_amdgcn_mfma_f32_16x16x32_bf16(a, b, acc[cg], 0, 0, 0); }
    }
}
DI void zero8(f32x4 (&a)[8]) {
#pragma unroll
    for (int i = 0; i < 8; ++i) a[i] = (f32x4){0.f, 0.f, 0.f, 0.f};
}
DI void kv_unit(const Inputs& in, int l, unsigned char* ws, int half, int u, LAS unsigned char* lds, int tid) {
    asm volatile("" : "+v"(tid));
    const int L = half ? 2048 : 4096, NC = L / 128, h = u & 3, sn = u >> 2, s = sn / NC, n = sn % NC, row0 = s * L + n * 128, pos0 = n * 128;
    const bf16_t* proj = (const bf16_t*)(ws + WS_PROJ); const float* rtc = (const float*)(ws + WS_RTC); const float* rts = (const float*)(ws + WS_RTS);
    bf16_t* KV = (bf16_t*)(ws + WS_KV);
    const float lgf = logsig(in.ret_decay[l * 8 + h]), lgb = logsig(in.ret_decay[l * 8 + 4 + h]);
    LAS unsigned char* VTt = lds; LAS unsigned char* KfT = lds + TILE_B; LAS unsigned char* KbT = lds + 2 * TILE_B;
    stage_T_b(VTt, proj + (size_t)row0 * PC + C_RV + 128 * h, tid);
    stage_rot_T2_b(KfT, KbT, proj + (size_t)row0 * PC + C_RK + 128 * h, rtc, rts, pos0, 0.088388347648318440f, lgf, lgb, tid);
    __syncthreads();
    const int wave = tid >> 6, lane = tid & 63, l15 = lane & 15, quad = lane >> 4;
    f32x4 af[8], ab[8]; zero8(af); zero8(ab);
    mma16(af, KfT, 16 * wave, VTt, lane); mma16(ab, KbT, 16 * wave, VTt, lane);
    bf16_t* of = KV + (size_t)(u * 2 + 0) * 16384; bf16_t* ob = KV + (size_t)(u * 2 + 1) * 16384;
#pragma unroll
    for (int cg = 0; cg < 8; ++cg) { const int e = 16 * cg + l15, d = 16 * wave + 4 * quad;
        u32x2 wf, wb2; wf.x = cvt_pk_bf16(af[cg][0], af[cg][1]); wf.y = cvt_pk_bf16(af[cg][2], af[cg][3]); wb2.x = cvt_pk_bf16(ab[cg][0], ab[cg][1]); wb2.y = cvt_pk_bf16(ab[cg][2], ab[cg][3]);
        *(u32x2*)(of + e * 128 + d) = wf; *(u32x2*)(ob + e * 128 + d) = wb2; }
    __syncthreads();
}
DI void scan(const Inputs& in, int l, unsigned char* ws, int half, int gtid, int NT) {
    const int L = half ? 2048 : 4096, NC = L / 128, NB = half ? 8 : 4;
    const bf16_t* KV = (const bf16_t*)(ws + WS_KV); bf16_t* SS = (bf16_t*)(ws + WS_KV + 32 * MiB);
    for (int idx = gtid; idx < NB * 32768; idx += NT) {
        const int elem = (idx & 4095) * 4, dir = (idx >> 12) & 1, h = (idx >> 13) & 3, s = idx >> 15;
        const float decay = __expf(128.f * logsig(in.ret_decay[l * 8 + dir * 4 + h]));
        const size_t base = ((size_t)(s * NC * 4 + h) * 2 + dir) * 16384 + elem;
        u32x2 v[32];
#pragma unroll
        for (int st = 0; st < 32; ++st) { const int n = dir ? NC - 1 - st : st; v[st] = st < NC ? *(const u32x2*)(KV + base + (size_t)n * 8 * 16384) : (u32x2){0u, 0u}; }
        float S0 = 0.f, S1 = 0.f, S2 = 0.f, S3 = 0.f;
#pragma unroll
        for (int st = 0; st < 32; ++st) { const int n = dir ? NC - 1 - st : st;
            if (st < NC) { u32x2 o; o.x = cvt_pk_bf16(S0, S1); o.y = cvt_pk_bf16(S2, S3); *(u32x2*)(SS + base + (size_t)n * 8 * 16384) = o;
                S0 = S0 * decay + bflo(v[st].x); S1 = S1 * decay + bfhi(v[st].x); S2 = S2 * decay + bflo(v[st].y); S3 = S3 * decay + bfhi(v[st].y); } }
    }
}
DI void out_unit(const Inputs& in, int l, unsigned char* ws, int half, int u, LAS unsigned char* lds, int tid) {
    asm volatile("" : "+v"(tid));
    const int L = half ? 2048 : 4096, NC = L / 128, h = u & 3, sn = u >> 2, s = sn / NC, n = sn % NC, row0 = s * L + n * 128, pos0 = n * 128;
    bf16_t* proj = (bf16_t*)(ws + WS_PROJ); const float* rtc = (const float*)(ws + WS_RTC); const float* rts = (const float*)(ws + WS_RTS);
    const bf16_t* SS = (const bf16_t*)(ws + WS_KV + 32 * MiB);
    const float lgf = logsig(in.ret_decay[l * 8 + h]), lgb = logsig(in.ret_decay[l * 8 + 4 + h]);
    const int wave = tid >> 6, lane = tid & 63, l15 = lane & 15, quad = lane >> 4;
    LAS unsigned char* Qt = lds; LAS unsigned char* Kt = lds + TILE_B; LAS unsigned char* VTt = lds + 2 * TILE_B; LAS unsigned char* Ps = lds + 3 * TILE_B + wave * (16 * TS * 2);
    stage_rot_rm_b(Qt, proj + (size_t)row0 * PC + C_RQ + 128 * h, rtc, rts, pos0, 1.0f, tid);
    stage_rot_rm_b(Kt, proj + (size_t)row0 * PC + C_RK + 128 * h, rtc, rts, pos0, 0.088388347648318440f, tid);
    stage_T_b(VTt, proj + (size_t)row0 * PC + C_RV + 128 * h, tid);
    __syncthreads();
    f32x4 O[8], F[8];
    zero8(F); mma16(F, Qt, 16 * wave, Kt, lane);
#pragma unroll
    for (int cg = 0; cg < 8; ++cg)
#pragma unroll
        for (int r = 0; r < 4; ++r) { const int i = 16 * wave + 4 * quad + r, j = 16 * cg + l15, df = i - j;
            const float fac = df >= 0 ? __expf((float)df * lgf) : __expf((float)(-df) * lgb);
            ((LAS bf16_t*)Ps)[sw(4 * quad + r, j)] = f2bf(F[cg][r] * fac); }
    LDS_WAIT();
    zero8(O); mma16(O, Ps, 0, VTt, lane);
    __syncthreads();
    stage_state(Kt, SS + (size_t)(u * 2 + 0) * 16384, tid); stage_state(VTt, SS + (size_t)(u * 2 + 1) * 16384, tid);
    __syncthreads();
    zero8(F); mma16(F, Qt, 16 * wave, Kt, lane);
#pragma unroll
    for (int r = 0; r < 4; ++r) { const int i = 16 * wave + 4 * quad + r; const float qwf = __expf((float)(i + 1) * lgf);
#pragma unroll
        for (int cg = 0; cg < 8; ++cg) O[cg][r] += qwf * F[cg][r]; }
    zero8(F); mma16(F, Qt, 16 * wave, VTt, lane);
    LAS bf16_t* Pn = (LAS bf16_t*)Ps;
#pragma unroll
    for (int r = 0; r < 4; ++r) { const int i = 16 * wave + 4 * quad + r; const float qwb = __expf((float)(128 - i) * lgb);
        float sm = 0.f;
#pragma unroll
        for (int cg = 0; cg < 8; ++cg) { O[cg][r] += qwb * F[cg][r]; sm += O[cg][r]; }
        sm += __shfl_xor(sm, 1); sm += __shfl_xor(sm, 2); sm += __shfl_xor(sm, 4); sm += __shfl_xor(sm, 8);
        const float mean = sm * (1.f / 128.f); float vs = 0.f;
#pragma unroll
        for (int cg = 0; cg < 8; ++cg) { const float dd = O[cg][r] - mean; vs += dd * dd; }
        vs += __shfl_xor(vs, 1); vs += __shfl_xor(vs, 2); vs += __shfl_xor(vs, 4); vs += __shfl_xor(vs, 8);
        const float rinv = __builtin_amdgcn_rsqf(vs * (1.f / 128.f) + EPS);
#pragma unroll
        for (int cg = 0; cg < 8; ++cg) Pn[(4 * quad + r) * TS + 16 * cg + l15] = f2bf((O[cg][r] - mean) * rinv);
    }
    LDS_WAIT();
    { const int rr = lane >> 2, part = lane & 3; bf16_t* rowp = proj + (size_t)(row0 + 16 * wave + rr) * PC + 128 * h + 32 * part;
      u32x4 gv[4];
#pragma unroll
      for (int q = 0; q < 4; ++q) gv[q] = *(const u32x4*)(rowp + C_RG + 8 * q);
#pragma unroll
      for (int q = 0; q < 4; ++q) { float g[8], o[8]; unpack8(gv[q], g); unpack8(*(const LAS u32x4*)(Pn + rr * TS + 32 * part + 8 * q), o);
#pragma unroll
          for (int e = 0; e < 8; ++e) o[e] = g[e] * sigmoidf_(g[e]) * o[e];
          u32x4 w; w.x = cvt_pk_bf16(o[0], o[1]); w.y = cvt_pk_bf16(o[2], o[3]); w.z = cvt_pk_bf16(o[4], o[5]); w.w = cvt_pk_bf16(o[6], o[7]);
          *(u32x4*)(rowp + C_RQ + 8 * q) = w; } }
    __syncthreads();
}
}


#define XB_TMO      128
#define XB_XCNT(j)  (256  + 64 * (j))
#define XB_XSUB(j)  (1280 + 64 * (j))
#define XB_XGEN(j)  (2304 + 64 * (j))
#define XB_TOP      3328
#define XB_TOPGEN   3392
#define XCD_BAR_WORDS 3456
#define XB_SPIN_CAP (1u << 22)
DI unsigned xb_ld(unsigned* p)              { return __hip_atomic_load(p, __ATOMIC_RELAXED, __HIP_MEMORY_SCOPE_AGENT); }
DI unsigned xb_add(unsigned* p, unsigned v) { return __hip_atomic_fetch_add(p, v, __ATOMIC_RELAXED, __HIP_MEMORY_SCOPE_AGENT); }
DI unsigned xb_xcc_id() { return (unsigned)__builtin_amdgcn_s_getreg((3 << 11) | 20) & 0xFu; }
#define XB_SPIN(cond, bar) do { unsigned _sp = 0; while (cond) { __builtin_amdgcn_s_sleep(1); \
    if ((++_sp & 255u) == 0u) { if (xb_ld(&(bar)[XB_TMO])) break; if (_sp > XB_SPIN_CAP) { atomicAdd(&(bar)[XB_TMO], 1u); break; } } } } while (0)
DI void xcd_barrier_complete(unsigned* bar, unsigned x, unsigned G, unsigned& nloc, unsigned& nx) {
    unsigned sum, cnt, mine, sp = 0u;
    for (;;) {
        sum = 0u; cnt = 0u; mine = 0u;
#pragma unroll
        for (unsigned j = 0; j < 16; ++j) { const unsigned c = xb_ld(&bar[XB_XCNT(j)]); sum += c; cnt += (c > 0u) ? 1u : 0u; mine = (j == x) ? c : mine; }
        if (sum == G) break;
        __builtin_amdgcn_s_sleep(1);
        if ((++sp & 255u) == 0u) { if (xb_ld(&bar[XB_TMO])) break; if (sp > XB_SPIN_CAP) { atomicAdd(&bar[XB_TMO], 1u); break; } }
    }
    nloc = mine > 0u ? mine : 1u; nx = cnt > 0u ? cnt : 1u;
}
DI void xcd_barrier(unsigned* bar, volatile LAS unsigned* st, bool leader, unsigned G) {
    asm volatile("s_waitcnt vmcnt(0)" ::: "memory");
    __syncthreads();
    if (leader) {
        const unsigned x = xb_xcc_id();
        __builtin_amdgcn_s_waitcnt(0);
        unsigned nloc = st[0], nx = st[1];
        if (nloc == 0u) { xcd_barrier_complete(bar, x, G, nloc, nx); st[0] = nloc; st[1] = nx; }
        const unsigned old = xb_add(&bar[XB_XSUB(x)], 1u);
        const unsigned gen = old / nloc;
        if (old + 1u == (gen + 1u) * nloc) {
            __builtin_amdgcn_fence(__ATOMIC_RELEASE, "agent");
            asm volatile("s_waitcnt vmcnt(0)" ::: "memory");
            const unsigned og = xb_add(&bar[XB_TOP], 1u);
            const unsigned tg = og / nx;
            if (og + 1u == (tg + 1u) * nx) xb_add(&bar[XB_TOPGEN], 1u);
            else XB_SPIN(xb_ld(&bar[XB_TOPGEN]) == tg, bar);
            __builtin_amdgcn_fence(__ATOMIC_ACQUIRE, "agent");
            xb_add(&bar[XB_XGEN(x)], 1u);
            asm volatile("s_waitcnt vmcnt(0)" ::: "memory");
        } else {
            XB_SPIN(xb_ld(&bar[XB_XGEN(x)]) == gen, bar);
            __builtin_amdgcn_fence(__ATOMIC_ACQUIRE, "agent");
            asm volatile("s_waitcnt vmcnt(0)" ::: "memory");
        }
    }
    __syncthreads();
}

struct SchedGrid { const char* A; const char* B; int nM, nN, G, c; size_t astep, bstep;
    DI bool next(int i, Unit& u) const { const int L = i * G + c; if (L >= nM * nN) return false; int pm, pn; pg8::tile_order(nM, nN, L, pm, pn);
        u.A = A + (size_t)pm * astep; u.B = B + (size_t)pn * bstep; u.pm = pm; u.pn = pn; u.z = 0; return true; } };
struct SchedA1 { const char* XN; const char* Win; const char* MN; const char* Wkv; int G, c, extra;
    DI bool next(int i, Unit& u) const { int L = i * G + c;
        if (L < 1920) { int pm, pn; pg8::tile_order(64, 30, L, pm, pn); u.A = XN + (size_t)pm * 256 * 1024 * 2; u.B = Win + (size_t)pn * 256 * 1024 * 2; u.pm = pm; u.pn = pn; u.z = 0; return true; }
        if (!extra) return false;
        L -= 1920;
        if (L < 48) { const int pm = L >> 2, pn = L & 3; u.A = MN + (size_t)pm * 256 * 1024 * 2; u.B = Wkv + (size_t)pn * 256 * 1024 * 2; u.pm = pm; u.pn = pn; u.z = 1; return true; }
        L -= 48;
        if (L < 48) { const int bm = L >> 2, pm = L & 3; u.A = Wkv + (size_t)(1024 + pm * 256) * 1024 * 2; u.B = MN + (size_t)bm * 256 * 1024 * 2; u.pm = pm; u.pn = 0; u.z = 2 + bm; return true; }
        return false; } };
struct FA1 { bf16_t *O, *KK, *VVT;
    DI void operator()(const Unit& u, int r, int c, f32x4 a, f32x4 b) const {
        if (u.z == 0) { const int col = u.pn * 256 + c;
            if (col >= C_G) {
                unsigned q[8];
#pragma unroll
                for (int e = 0; e < 4; ++e) { q[e] = (unsigned)(sigmoidf_(a[e]) * 255.f + 0.5f); q[4 + e] = (unsigned)(sigmoidf_(b[e]) * 255.f + 0.5f); }
                u32x2 w; w.x = q[0] | (q[1] << 8) | (q[2] << 16) | (q[3] << 24); w.y = q[4] | (q[5] << 8) | (q[6] << 16) | (q[7] << 24);
                *(u32x2*)((unsigned char*)(O + (size_t)(u.pm * 256 + r) * PC + C_G) + (col - C_G)) = w; }
            else *(u32x4*)(O + (size_t)(u.pm * 256 + r) * PC + col) = pack8(a, b); }
        else if (u.z == 1) *(u32x4*)(KK + (size_t)(u.pm * 256 + r) * 1024 + u.pn * 256 + c) = pack8(a, b);
        else *(u32x4*)(VVT + ((size_t)(u.z - 2) * 1024 + u.pm * 256 + r) * 256 + c) = pack8(a, b); } };
struct SchedBranch { const char* proj; const char* W; int G, c;
    DI bool next(int i, Unit& u) const { const int mac = (i / 3) * G + c, br = i % 3; if (mac >= 256) return false; int pm, pn; pg8::tile_order(64, 4, mac, pm, pn);
        const int acol = br == 0 ? C_YH : (br == 1 ? C_RQ : C_AQ);
        u.A = proj + ((size_t)pm * 256 * PC + acol) * 2; u.B = W + ((size_t)br * 1024 * 512 + (size_t)pn * 256 * 512) * 2; u.pm = pm; u.pn = pn; u.z = br; return true; } };
struct SchedX1 { const char* XN; const char* MN; const char* Wq; const char* Wkv; int G, c;
    DI bool next(int i, Unit& u) const { int L = i * G + c;
        if (L < 512) { int pm, pn; pg8::tile_order(128, 4, L, pm, pn); u.A = XN + (size_t)pm * 256 * 1024 * 2; u.B = Wq + (size_t)pn * 256 * 1024 * 2; u.pm = pm; u.pn = pn; u.z = 0; return true; }
        L -= 512;
        if (L < 48) { const int pm = L >> 2, pn = L & 3; u.A = MN + (size_t)pm * 256 * 1024 * 2; u.B = Wkv + (size_t)pn * 256 * 1024 * 2; u.pm = pm; u.pn = pn; u.z = 1; return true; }
        L -= 48;
        if (L < 48) { const int bm = L >> 2, pm = L & 3; u.A = Wkv + (size_t)(1024 + pm * 256) * 1024 * 2; u.B = MN + (size_t)bm * 256 * 1024 * 2; u.pm = pm; u.pn = 0; u.z = 2 + bm; return true; }
        return false; } };
DI int mem_batch(int row0) { return row0 < 16384 ? (row0 >> 12) : 4 + ((row0 - 16384) >> 11); }
struct SchedX2 { const char* QX; const char* KK; int G, c;
    DI bool next(int i, Unit& u) const { const int L = i * G + c; if (L >= 512) return false; const int pm = L >> 2, h = L & 3, bm = mem_batch(pm * 256);
        u.A = QX + ((size_t)pm * 256 * 1024 + 256 * h) * 2; u.B = KK + ((size_t)bm * 256 * 1024 + 256 * h) * 2; u.pm = pm; u.pn = h; u.z = h; return true; } };
struct SchedX3 { const char* P; const char* VVT; int G, c;
    DI bool next(int i, Unit& u) const { const int L = i * G + c; if (L >= 512) return false; const int pm = L >> 2, h = L & 3, bm = mem_batch(pm * 256);
        u.A = P + ((size_t)pm * 256 * 1024 + 256 * h) * 2; u.B = VVT + ((size_t)(bm * 1024 + 256 * h) * 256) * 2; u.pm = pm; u.pn = h; u.z = h; return true; } };

struct FProj { bf16_t* O;
    DI void operator()(const Unit& u, int r, int c, f32x4 a, f32x4 b) const { const int col = u.pn * 256 + c;
        if (col >= C_G) {
#pragma unroll
            for (int e = 0; e < 4; ++e) { a[e] = sigmoidf_(a[e]); b[e] = sigmoidf_(b[e]); } }
        *(u32x4*)(O + (size_t)(u.pm * 256 + r) * PC + col) = pack8(a, b); } };
template <int ACT> struct FStore { bf16_t* O; int ldc; float sc;
    DI void operator()(const Unit& u, int r, int c, f32x4 a, f32x4 b) const {
        if (ACT == 1) {
#pragma unroll
            for (int e = 0; e < 4; ++e) { const float x = fmaxf(a[e], 0.f), y = fmaxf(b[e], 0.f); a[e] = x * x; b[e] = y * y; } }
        *(u32x4*)(O + (size_t)(u.pm * 256 + r) * ldc + u.pn * 256 + c) = pack8(a * sc, b * sc); } };
struct EpiBranch { const bf16_t* proj; bf16_t* M;
    DI void operator()(f32x4 (&acc)[2][2][4][2], const Unit& u, int wr, int wc, int fr, int fq, LAS unsigned char*) const {
        asm volatile("" : "+v"(fr), "+v"(fq));
#pragma unroll
        for (int ai = 0; ai < 2; ++ai) {
            u32x2 gv[4][2]; u32x4 pv[4][2];
#pragma unroll
            for (int m = 0; m < 4; ++m)
#pragma unroll
                for (int bj = 0; bj < 2; ++bj) { const int row = u.pm * 256 + ai * 128 + wr * 64 + m * 16 + fr, col = u.pn * 256 + bj * 128 + wc * 32 + 8 * fq;
                    gv[m][bj] = *(const u32x2*)((const unsigned char*)(proj + (size_t)row * PC + C_G) + u.z * 1024 + col);
                    pv[m][bj] = (u32x4){0u, 0u, 0u, 0u}; if (u.z) pv[m][bj] = *(const u32x4*)(M + (size_t)row * 1024 + col); }
#pragma unroll
            for (int m = 0; m < 4; ++m)
#pragma unroll
                for (int bj = 0; bj < 2; ++bj) { const int row = u.pm * 256 + ai * 128 + wr * 64 + m * 16 + fr, col = u.pn * 256 + bj * 128 + wc * 32 + 8 * fq;
                    float g[8], p[8]; unpack8g(pv[m][bj], p);
#pragma unroll
                    for (int e = 0; e < 4; ++e) { g[e] = (float)((gv[m][bj].x >> (8 * e)) & 0xffu) * (1.f / 255.f); g[4 + e] = (float)((gv[m][bj].y >> (8 * e)) & 0xffu) * (1.f / 255.f); }
                    f32x4 a = acc[ai][bj][m][0], b = acc[ai][bj][m][1];
#pragma unroll
                    for (int e = 0; e < 4; ++e) { a[e] = a[e] * g[e] + p[e]; b[e] = b[e] * g[4 + e] + p[4 + e]; }
                    *(u32x4*)(M + (size_t)row * 1024 + col) = pack8(a, b); }
        }
    } };
struct FX1 { bf16_t *QX, *KK, *VVT;
    DI void operator()(const Unit& u, int r, int c, f32x4 a, f32x4 b) const {
        if (u.z == 0) *(u32x4*)(QX + (size_t)(u.pm * 256 + r) * 1024 + u.pn * 256 + c) = pack8(a * 0.0625f, b * 0.0625f);
        else if (u.z == 1) *(u32x4*)(KK + (size_t)(u.pm * 256 + r) * 1024 + u.pn * 256 + c) = pack8(a, b);
        else *(u32x4*)(VVT + ((size_t)(u.z - 2) * 1024 + u.pm * 256 + r) * 256 + c) = pack8(a, b); } };

__global__ void __launch_bounds__(512, 2) mega(Args args) {
    extern __shared__ __attribute__((aligned(16))) unsigned char lds_g[];
    cg::grid_group grid = cg::this_grid();
    LAS unsigned char* lds = (LAS unsigned char*)lds_g;
    LAS unsigned char* lx = lds + LDS_X;
    const int G0 = gridDim.x, bx0 = blockIdx.x, wave0 = __builtin_amdgcn_readfirstlane(threadIdx.x >> 6);
    const int vcu0 = (G0 % 8 == 0) ? (bx0 % 8) * (G0 / 8) + bx0 / 8 : bx0;
    const int lo = args.ph_lo, hi = args.ph_hi; int ph = 0;
    { const int t0 = opaque_tid(wave0);
      if (t0 < 2) ((volatile LAS unsigned*)(lds + LDS_ST))[t0] = 0u;
      __syncthreads();
      if (t0 == 0) (void)xb_add(&((unsigned*)args.ws)[XB_XCNT(xb_xcc_id())], 1u); }
    typedef const __attribute__((address_space(4))) Args* KArgsP;
#if defined(__HIP_DEVICE_COMPILE__)
#define LOAD_ARGS(p) (*(p))
#else
#define LOAD_ARGS(p) (args)
#endif
#define PH_BEGIN if (ph >= lo && ph < hi) { KArgsP kp_ = (KArgsP)__builtin_amdgcn_kernarg_segment_ptr(); asm volatile("" : "+s"(kp_)); const Args A_ = LOAD_ARGS(kp_); \
        const Inputs& in = A_.in; unsigned char* ws = A_.ws; float* xo = A_.out; (void)in; (void)xo; \
        int G = G0, bx = bx0, vcu = vcu0, wave = wave0; asm volatile("" : "+s"(G), "+s"(bx), "+s"(vcu), "+s"(wave)); \
        const int tid = opaque_tid(wave), lane = tid & 63, gtid = bx * 512 + tid, gw = vcu * 8 + wave, NGW = G * 8, NT = G * 512; (void)lane; (void)gtid; (void)gw; (void)NGW; (void)NT; \
        const char* wb = (const char*)(ws + WS_WB); bf16_t* XN = (bf16_t*)xo; bf16_t* XB = (bf16_t*)(ws + WS_XN); (void)XB; \
        bf16_t* MNb = XN + (size_t)TT * D; bf16_t* KKb = MNb + (size_t)3072 * D; bf16_t* VVTb = KKb + (size_t)3072 * D; (void)MNb; (void)KKb; (void)VVTb;     bf16_t* R = (bf16_t*)(ws + WS_R); bf16_t* proj = (bf16_t*)(ws + WS_PROJ); (void)wb; (void)XN; (void)R; (void)proj;
#define PH_END } ++ph; if (ph > lo && ph < hi) { if (lo < 0) grid.sync(); else { KArgsP kq_ = (KArgsP)__builtin_amdgcn_kernarg_segment_ptr(); asm volatile("" : "+s"(kq_)); \
        xcd_barrier((unsigned*)LOAD_ARGS(kq_).ws, (volatile LAS unsigned*)(lds + LDS_ST), opaque_tid(wave0) == 0, (unsigned)G0); } }

    PH_BEGIN
        make_tables(ws, gtid, NT);
        convert_weights(in, 0, ws, lds, gw, NGW, wave, lane);
        filter_gen(in, 0, ws, lds, vcu, G, wave, tid);
        for (int m0 = gw; m0 < TT; m0 += 4 * NGW) {
            f32x4 v[4][4];
#pragma unroll
            for (int q = 0; q < 4; ++q) { const int m = m0 + q * NGW; const float* xi = m < HT ? in.x_prompt + (size_t)m * D : in.x_sample + (size_t)(m - HT) * D;
#pragma unroll
                for (int j = 0; j < 4; ++j) v[q][j] = *(const f32x4*)(xi + 4 * lane + 256 * j); }
            float ss[4];
#pragma unroll
            for (int q = 0; q < 4; ++q) { ss[q] = 0.f; const size_t m = (size_t)m0 + q * NGW;
#pragma unroll
                for (int j = 0; j < 4; ++j) { u32x2 w; w.x = cvt_pk_bf16(v[q][j][0], v[q][j][1]); w.y = cvt_pk_bf16(v[q][j][2], v[q][j][3]); *(u32x2*)(XB + m * D + 4 * lane + 256 * j) = w;
                    v[q][j] = (f32x4){bflo(w.x), bfhi(w.x), bflo(w.y), bfhi(w.y)};
                    ss[q] += (v[q][j][0] * v[q][j][0] + v[q][j][1] * v[q][j][1]) + (v[q][j][2] * v[q][j][2] + v[q][j][3] * v[q][j][3]); } }
#pragma unroll
            for (int o = 1; o < 64; o <<= 1)
#pragma unroll
                for (int q = 0; q < 4; ++q) ss[q] += __shfl_xor(ss[q], o);
#pragma unroll
            for (int q = 0; q < 4; ++q) { const float rinv = __builtin_amdgcn_rsqf(ss[q] * (1.f / 1024.f) + EPS); const size_t m = (size_t)m0 + q * NGW;
#pragma unroll
                for (int j = 0; j < 4; ++j) { const f32x4 g = *(const f32x4*)(in.g_mix_pre + 4 * lane + 256 * j); const f32x4 o = v[q][j] * rinv * g;
                    u32x2 w; w.x = cvt_pk_bf16(o[0], o[1]); w.y = cvt_pk_bf16(o[2], o[3]); *(u32x2*)(XN + m * D + 4 * lane + 256 * j) = w; } }
        }
    PH_END

    for (int l = 0; l < DEPTH; ++l) {
        for (int half = 0; half < 2; ++half) {
            const int L = half ? 2048 : 4096;
            PH_BEGIN
                SchedA1 S{(const char*)(XN + (size_t)half * HT * D), wb + WB_IN, (const char*)MNb, wb + WB_XKV, G, bx, half};
                pg8::EpiRows<FA1> E{FA1{proj, KKb, VVTb}};
                pg8::gemm_phase(wave, lds, lx, GemmP{1024, 1024, 1024}, S, E);
            PH_END
            PH_BEGIN
                prep_attn(in, l, ws, half, gw, NGW, lane);
                prep_hyena(in, l, ws, half, vcu, G, tid);
                for (int u = vcu; u < 512; u += G) ret::kv_unit(in, l, ws, half, u, lds, tid);
            PH_END
            PH_BEGIN
                ret::scan(in, l, ws, half, gtid, NT);
                const int nqb = L / 256;
                for (int u = vcu; u < 256; u += G) { const int qb = u % nqb, sh = u / nqb, g2 = sh & 1, kvh = (sh >> 1) & 1, s = sh >> 2, h = 2 * kvh + g2;
                    bf16_t* Qb = proj + (size_t)(s * L + qb * 256) * PC + C_AQ + 128 * h;
                    const bf16_t* Kh = proj + (size_t)(s * L) * PC + C_AK + 128 * kvh; const bf16_t* Vh = proj + (size_t)(s * L) * PC + C_AV + 128 * kvh;
                    attn::attn_dense_body(wave, Qb, Kh, Vh, Qb, L, (char*)lds_g); }
                for (int c = vcu; c < 512; c += G) hyena_unit(in, l, ws, half, c, lds, tid);
            PH_END
            PH_BEGIN
                for (int u = vcu; u < 512; u += G) ret::out_unit(in, l, ws, half, u, lds, tid);
                post_hyena(ws, half, lds, vcu, G, tid);
            PH_END
            PH_BEGIN
                SchedBranch S{(const char*)proj, wb + WB_BR, G, bx};
                EpiBranch E{proj, XN + (size_t)half * HT * D};
                pg8::gemm_phase(wave, lds, lx, GemmP{PC, 512, 512}, S, E);
            PH_END
            PH_BEGIN
                SchedGrid S{(const char*)(XN + (size_t)half * HT * D), wb + WB_OUT, 64, 4, G, bx, (size_t)256 * 1024 * 2, (size_t)256 * 1024 * 2};
                pg8::EpiRows<FStore<0>> E{FStore<0>{R + (size_t)half * HT * D, 1024, 1.f}};
                pg8::gemm_phase(wave, lds, lx, GemmP{1024, 1024, 1024}, S, E);
            PH_END
            PH_BEGIN
                for (int m = gw; m < HT; m += 4 * NGW) norm_rows<true, 4>(XB, R, in.g_mix_post + l * D, XB, in.g_x_pre + l * D, XN, (size_t)half * HT + m, (size_t)NGW, lane);
                if (half == 0) for (int m = gw; m < 3072; m += NGW) { const float* mi = m < 1024 ? in.mem_prompt + (size_t)m * D : in.mem_sample + (size_t)(m - 1024) * D;
                    norm_row<false, true>(mi, nullptr, nullptr, nullptr, in.g_mem + l * D, MNb + (size_t)m * D, lane); }
            PH_END
        }
        PH_BEGIN
            SchedGrid S{(const char*)XN, wb + WB_XQ, 128, 4, G, bx, (size_t)256 * 1024 * 2, (size_t)256 * 1024 * 2};
            pg8::EpiRows<FStore<0>> E{FStore<0>{(bf16_t*)(ws + WS_QX), 1024, 0.0625f}};
            pg8::gemm_phase(wave, lds, lx, GemmP{1024, 1024, 1024}, S, E);
        PH_END
        PH_BEGIN
            SchedX2 S{(const char*)(ws + WS_QX), (const char*)KKb, G, bx};
            pg8::EpiSoftmax E{(bf16_t*)(ws + WS_P), 1024};
            pg8::gemm_phase(wave, lds, lx, GemmP{1024, 1024, 256}, S, E);
        PH_END
        PH_BEGIN
            SchedX3 S{(const char*)(ws + WS_P), (const char*)VVTb, G, bx};
            pg8::EpiRows<FStore<0>> E{FStore<0>{(bf16_t*)(ws + WS_OX), 1024, 1.f}};
            pg8::gemm_phase(wave, lds, lx, GemmP{1024, 256, 256}, S, E);
        PH_END
        PH_BEGIN
            SchedGrid S{(const char*)(ws + WS_OX), wb + WB_XO, 128, 4, G, bx, (size_t)256 * 1024 * 2, (size_t)256 * 1024 * 2};
            pg8::EpiRows<FStore<0>> E{FStore<0>{R, 1024, 1.f}};
            pg8::gemm_phase(wave, lds, lx, GemmP{1024, 1024, 1024}, S, E);
        PH_END
        PH_BEGIN
            for (int m = gw; m < TT; m += 4 * NGW) norm_rows<true, 4>(XB, R, in.g_x_post + l * D, XB, in.g_ff_pre + l * D, XN, (size_t)m, (size_t)NGW, lane);
        PH_END
        PH_BEGIN
            SchedGrid S{(const char*)XN, wb + WB_F1, 128, 16, G, bx, (size_t)256 * 1024 * 2, (size_t)256 * 1024 * 2};
            pg8::EpiRows<FStore<1>> E{FStore<1>{(bf16_t*)(ws + WS_U), 4096, 1.f}};
            pg8::gemm_phase(wave, lds, lx, GemmP{1024, 1024, 1024}, S, E);
        PH_END
        PH_BEGIN
            SchedGrid S{(const char*)(ws + WS_U), wb + WB_F2, 128, 4, G, bx, (size_t)256 * 4096 * 2, (size_t)256 * 4096 * 2};
            pg8::EpiRows<FStore<0>> E{FStore<0>{R, 1024, 1.f}};
            pg8::gemm_phase(wave, lds, lx, GemmP{4096, 4096, 4096}, S, E);
        PH_END
        PH_BEGIN
            const bool more = l + 1 < DEPTH;
            if (more) { for (int m = gw; m < TT; m += 4 * NGW) norm_rows<true, 4>(XB, R, in.g_ff_post + l * D, XB, in.g_mix_pre + (l + 1) * D, XN, (size_t)m, (size_t)NGW, lane); }
            else { for (int m = gw; m < TT; m += 4 * NGW) norm_rows<false, 4>(XB, R, in.g_ff_post + l * D, xo, nullptr, nullptr, (size_t)m, (size_t)NGW, lane); }
            if (more) { convert_weights(in, l + 1, ws, lds, gw, NGW, wave, lane); filter_gen(in, l + 1, ws, lds, vcu, G, wave, tid); }
        PH_END
    }
#undef PH_BEGIN
#undef PH_END
}

extern "C" void kernel_launch(void* const* d_in, const int* in_sizes, int n_in, void* d_out, int out_size, void* d_ws, size_t ws_size, hipStream_t stream) {
    static int grid = 0;
    if (grid == 0) {
        if (n_in != 29 || out_size != TT * D || ws_size < WS_END) { fprintf(stderr, "kernel_launch: unexpected shapes: n_in %d out %d ws %zu (need %zu)\n", n_in, out_size, ws_size, (size_t)WS_END); grid = -1; return; }
        int dev = 0, cus = 0, per_cu = 0;
        hipGetDevice(&dev); hipDeviceGetAttribute(&cus, hipDeviceAttributeMultiprocessorCount, dev);
        if (hipFuncSetAttribute((const void*)mega, hipFuncAttributeMaxDynamicSharedMemorySize, LDS_BYTES) != hipSuccess) { fprintf(stderr, "kernel_launch: hipFuncSetAttribute failed\n"); grid = -1; return; }
        if (hipOccupancyMaxActiveBlocksPerMultiprocessor(&per_cu, (const void*)mega, 512, LDS_BYTES) != hipSuccess || per_cu < 1) { fprintf(stderr, "kernel_launch: occupancy query gave %d\n", per_cu); per_cu = 1; }
        (void)hipGetLastError();
        grid = cus * 1;
    }
    if (grid < 0) return;
    Args a{};
    const float** ip = (const float**)&a.in;
    for (int i = 0; i < 29; ++i) ip[i] = (const float*)d_in[i];
    a.out = (float*)d_out; a.ws = (unsigned char*)d_ws; a.ph_lo = 0; a.ph_hi = 1 << 30;
    (void)hipMemsetAsync(d_ws, 0, 16384, stream);
    void* params[] = {&a};
    const hipError_t e = hipLaunchCooperativeKernel((const void*)mega, dim3(grid), dim3(512), params, LDS_BYTES, stream);
    if (e != hipSuccess) fprintf(stderr, "kernel_launch: cooperative launch failed: %s (grid %d)\n", hipGetErrorString(e), grid);
}
```

```cpp
#include <hip/hip_runtime.h>
#include <hip/hip_cooperative_groups.h>
#include <cstdio>
#include <cstdint>
namespace cg = cooperative_groups;

#define LAS __attribute__((address_space(3)))
#define DI __device__ __forceinline__
typedef unsigned short bf16_t;
typedef short bf16x8 __attribute__((ext_vector_type(8)));
typedef short s16x4 __attribute__((ext_vector_type(4)));
typedef float f32x4 __attribute__((ext_vector_type(4)));
typedef float f32x2 __attribute__((ext_vector_type(2)));
typedef float f32x8 __attribute__((ext_vector_type(8)));
typedef float f32x16 __attribute__((ext_vector_type(16)));
typedef unsigned u32x4 __attribute__((ext_vector_type(4)));
typedef unsigned u32x2 __attribute__((ext_vector_type(2)));

constexpr int D = 1024, TT = 32768, HT = 16384, DEPTH = 4, DFF = 4096;
constexpr int PC = 8192;
constexpr int C_X0 = 0, C_X1 = 512, C_V = 1024, C_RQ = 1536, C_RK = 2048, C_RV = 2560, C_RG = 3072, C_AQ = 3584, C_AK = 4096, C_AV = 4352, C_G = 4608, C_YH = 7680;
constexpr int INC = 7680;
constexpr float EPS = 1e-6f;

constexpr size_t MiB = 1u << 20;
constexpr size_t WS_RTC = 1 * MiB, WS_RTS = 2 * MiB, WS_AXC = 3 * MiB, WS_AXS = 3 * MiB + 65536;
constexpr int FRS0 = 8192 + 64, FRS1 = 4096 + 64;
constexpr size_t WS_FR0 = 4 * MiB, WS_FR1 = WS_FR0 + (size_t)512 * FRS0 * 2;
constexpr size_t WS_WB = 17 * MiB;
constexpr size_t WB_IN = 0, WB_BR = WB_IN + (size_t)INC * 1024 * 2, WB_OUT = WB_BR + (size_t)3 * 1024 * 512 * 2, WB_XQ = WB_OUT + (size_t)1024 * 1024 * 2,
                 WB_XKV = WB_XQ + (size_t)1024 * 1024 * 2, WB_XO = WB_XKV + (size_t)2048 * 1024 * 2, WB_F1 = WB_XO + (size_t)1024 * 1024 * 2, WB_F2 = WB_F1 + (size_t)4096 * 1024 * 2,
                 WB_END = WB_F2 + (size_t)4096 * 1024 * 2;
static_assert(WB_END == 44 * MiB, "wb");
constexpr size_t WS_XN = 61 * MiB, WS_R = 125 * MiB, WS_BIG = 189 * MiB;
constexpr size_t WS_PROJ = WS_BIG, WS_ZT = WS_BIG + 256 * MiB, WS_X0T = WS_ZT + 16 * MiB, WS_FRO0 = WS_X0T + 16 * MiB, WS_FRO1 = WS_FRO0 + (size_t)512 * FRS0 * 2, WS_END = WS_FRO1 + (size_t)512 * FRS1 * 2;
constexpr size_t WS_QX = WS_BIG, WS_P = WS_BIG + 64 * MiB, WS_OX = WS_BIG + 128 * MiB, WS_MN = WS_BIG + 192 * MiB, WS_KK = WS_MN + 6 * MiB, WS_VVT = WS_KK + 6 * MiB;
constexpr size_t WS_U = WS_BIG;
constexpr size_t WS_KV = WS_R;

constexpr int LDS_BYTES = 147456;
constexpr int LDS_X = 131072;
constexpr int LDS_ST = 147456 - 64;

typedef __bf16 bf16x2_t __attribute__((ext_vector_type(2)));
DI unsigned cvt_pk_bf16(float lo, float hi) { const f32x2 v = {lo, hi}; return __builtin_bit_cast(unsigned, __builtin_convertvector(v, bf16x2_t)); }
DI bf16_t f2bf(float f) { return __builtin_bit_cast(bf16_t, (__bf16)f); }
DI float bf2f(bf16_t v) { return __uint_as_float(((unsigned)v) << 16); }
DI float bflo(unsigned w) { return __uint_as_float(w << 16); }
DI float bfhi(unsigned w) { return __uint_as_float(w & 0xffff0000u); }
DI float wave_sum(float v) {
#pragma unroll
    for (int o = 1; o < 64; o <<= 1) v += __shfl_xor(v, o);
    return v;
}
DI float sigmoidf_(float x) { return __builtin_amdgcn_rcpf(1.f + __builtin_amdgcn_exp2f(-1.4426950408889634f * x)); }
#define LDS_WAIT() asm volatile("s_waitcnt lgkmcnt(0)" ::: "memory")
DI void unpack8g(const u32x4 w, float (&f)[8]) { f[0] = bflo(w.x); f[1] = bfhi(w.x); f[2] = bflo(w.y); f[3] = bfhi(w.y); f[4] = bflo(w.z); f[5] = bfhi(w.z); f[6] = bflo(w.w); f[7] = bfhi(w.w); }
DI int opaque_tid(int wave) { int t = wave * 64 + (int)__builtin_amdgcn_mbcnt_hi(~0u, __builtin_amdgcn_mbcnt_lo(~0u, 0u)); asm volatile("" : "+v"(t)); return t; }

namespace pg8 {
constexpr int BM = 256, BK = 64, HALF = 128, HTB = HALF * BK * 2, STAGE_BYTES = 8 * HTB, NXCD = 8, WGM = 8;
__host__ __device__ __forceinline__ int lds_byte(int r, int c) { const int st = (r >> 4) * 2 + (c >> 5), rr = r & 15, cc = c & 31, ob = rr * 64 + cc * 2; return st * 1024 + (ob ^ (((ob >> 9) & 1) << 5)); }
__host__ __device__ __forceinline__ void stage_rc(int b, int& R, int& C) { const int st = b / 1024, sb = b % 1024, swz = sb ^ (((sb >> 9) & 1) << 5); R = (st >> 1) * 16 + swz / 64; C = (st & 1) * 32 + (swz % 64) / 2; }
__host__ __device__ __forceinline__ int perm32(int rho) { const int n = rho >> 4, i = rho & 15; return 8 * (i >> 2) + 4 * n + (i & 3); }

struct Unit { const char* A; const char* B; int pm, pn, z; };
struct GemmP { int lda, ldb, K; };

DI void tile_order(int nM, int nN, int L, int& pm, int& pn) {
    const int nwg = nM * nN; int wgid = L;
    { const int q = nwg / NXCD, r = nwg % NXCD, xcd = wgid % NXCD, off = wgid / NXCD; wgid = (xcd < r ? xcd * (q + 1) : r * (q + 1) + (xcd - r) * q) + off; }
    const int nig = WGM * nN, gid = wgid / nig, fm = gid * WGM, gsz = (nM - fm) < WGM ? (nM - fm) : WGM;
    pm = fm + ((wgid % nig) % gsz); pn = (wgid % nig) / gsz;
}

template <class F> struct EpiRows {
    F f;
    DI void operator()(f32x4 (&acc)[2][2][4][2], const Unit& u, int wr, int wc, int fr, int fq, LAS unsigned char*) const {
        asm volatile("" : "+v"(fr), "+v"(fq));
#pragma unroll
        for (int ai = 0; ai < 2; ++ai)
#pragma unroll
            for (int m = 0; m < 4; ++m) { const int r = ai * HALF + wr * 64 + m * 16 + fr;
#pragma unroll
                for (int bj = 0; bj < 2; ++bj) { const int c = bj * HALF + wc * 32 + 8 * fq; f(u, r, c, acc[ai][bj][m][0], acc[ai][bj][m][1]); } }
    }
};
DI u32x4 pack8(f32x4 a, f32x4 b) { u32x4 w; w.x = cvt_pk_bf16(a[0], a[1]); w.y = cvt_pk_bf16(a[2], a[3]); w.z = cvt_pk_bf16(b[0], b[1]); w.w = cvt_pk_bf16(b[2], b[3]); return w; }

struct EpiSoftmax {
    bf16_t* O; int ldc;
    DI void operator()(f32x4 (&acc)[2][2][4][2], const Unit& u, int wr, int wc, int fr, int fq, LAS unsigned char* lx) const {
        asm volatile("" : "+v"(fr), "+v"(fq));
        LAS f32x2* X = (LAS f32x2*)lx;
#pragma unroll
        for (int ai = 0; ai < 2; ++ai)
#pragma unroll
            for (int m = 0; m < 4; ++m) {
                float mx = -3.0e38f;
#pragma unroll
                for (int bj = 0; bj < 2; ++bj)
#pragma unroll
                    for (int n = 0; n < 2; ++n) { const f32x4 x = acc[ai][bj][m][n]; mx = fmaxf(mx, fmaxf(fmaxf(x[0], x[1]), fmaxf(x[2], x[3]))); }
                mx = fmaxf(mx, __shfl_xor(mx, 16)); mx = fmaxf(mx, __shfl_xor(mx, 32));
                float s = 0.f;
#pragma unroll
                for (int bj = 0; bj < 2; ++bj)
#pragma unroll
                    for (int n = 0; n < 2; ++n) { f32x4 x = acc[ai][bj][m][n];
#pragma unroll
                        for (int e = 0; e < 4; ++e) { x[e] = __expf(x[e] - mx); s += x[e]; }
                        acc[ai][bj][m][n] = x; }
                s += __shfl_xor(s, 16); s += __shfl_xor(s, 32);
                if (fq == 0) X[(ai * HALF + wr * 64 + m * 16 + fr) * 4 + wc] = (f32x2){mx, s};
                __builtin_amdgcn_sched_barrier(0);
            }
        LDS_WAIT(); __builtin_amdgcn_s_barrier(); asm volatile("" ::: "memory");
#pragma unroll
        for (int ai = 0; ai < 2; ++ai)
#pragma unroll
            for (int m = 0; m < 4; ++m) {
                const int r = ai * HALF + wr * 64 + m * 16 + fr;
                const f32x2 a = X[r * 4 + 0], b = X[r * 4 + 1], c = X[r * 4 + 2], d = X[r * 4 + 3];
                const float M = fmaxf(fmaxf(a.x, b.x), fmaxf(c.x, d.x));
                const float S = a.y * __expf(a.x - M) + b.y * __expf(b.x - M) + c.y * __expf(c.x - M) + d.y * __expf(d.x - M);
                const float fac = __expf(X[r * 4 + wc].x - M) / S;
                bf16_t* rowp = O + (size_t)(u.pm * BM + r) * ldc + u.z * 256 + wc * 32 + 8 * fq;
#pragma unroll
                for (int bj = 0; bj < 2; ++bj) *(u32x4*)(rowp + bj * HALF) = pack8(acc[ai][bj][m][0] * fac, acc[ai][bj][m][1] * fac);
                __builtin_amdgcn_sched_barrier(0);
            }
        LDS_WAIT(); __builtin_amdgcn_s_barrier(); asm volatile("" ::: "memory");
    }
};

template <class Epi, class Sched>
DI void gemm_phase(int wave_, LAS unsigned char* lds, LAS unsigned char* lx, const GemmP g, const Sched& S, const Epi& E) {
    const int tid = opaque_tid(wave_), wid = __builtin_amdgcn_readfirstlane(tid >> 6), lane = tid & 63, wr = wid >> 2, wc = wid & 3, fr = lane & 15, fq = lane >> 4;
    const int K = g.K, nt = K / BK;
    unsigned voffA[2], voffB[2];
#pragma unroll
    for (int i = 0; i < 2; ++i) { int R, C; stage_rc(tid * 16 + i * 8192, R, C); const int Rb = (R & ~31) + perm32(R & 31);
        voffA[i] = (unsigned)(R * g.lda + C) * 2u; voffB[i] = (unsigned)(Rb * g.ldb + C) * 2u; }
    const size_t kstep = (size_t)(BK * 2);
    const size_t hstepA = (size_t)HALF * g.lda * 2, hstepB = (size_t)HALF * g.ldb * 2;
    const unsigned ldsw = (unsigned)wid * 1024u;
    const int aoff = lds_byte(wr * 64 + fr, fq * 8), boff = lds_byte(wc * 32 + fr, fq * 8);
#define PG8_SA(b, h) (((b) * 2 + (h)) * HTB)
#define PG8_SB(b, h) ((4 + (b) * 2 + (h)) * HTB)
#define PG8_STAGE(bufoff, gbase, voff) do { _Pragma("unroll") for (int _i = 0; _i < 2; ++_i) \
        __builtin_amdgcn_global_load_lds((const unsigned*)((const char*)(gbase) + (voff)[_i]), (LAS unsigned*)(lds + (bufoff) + ldsw + _i * 8192), 16, 0, 0); } while (0)
#define PG8_LDA(dst, b, h) do { _Pragma("unroll") for (int m = 0; m < 4; ++m) _Pragma("unroll") for (int k = 0; k < 2; ++k) dst[m][k] = *(const LAS bf16x8*)(lds + PG8_SA(b, h) + aoff + m * 2048 + k * 1024); } while (0)
#define PG8_LDB(dst, b, h) do { _Pragma("unroll") for (int n = 0; n < 2; ++n) _Pragma("unroll") for (int k = 0; k < 2; ++k) dst[n][k] = *(const LAS bf16x8*)(lds + PG8_SB(b, h) + boff + n * 2048 + k * 1024); } while (0)
#define PG8_MMA(ai, bj, At, Bt) do { __builtin_amdgcn_s_setprio(1); _Pragma("unroll") for (int m = 0; m < 4; ++m) _Pragma("unroll") for (int n = 0; n < 2; ++n) _Pragma("unroll") for (int k = 0; k < 2; ++k) \
        acc[ai][bj][m][n] = __builtin_amdgcn_mfma_f32_16x16x32_bf16(Bt[n][k], At[m][k], acc[ai][bj][m][n], 0, 0, 0); __builtin_amdgcn_s_setprio(0); } while (0)
#define PG8_WAIT_V(n) asm volatile("s_waitcnt vmcnt(" #n ")" ::: "memory")
#define PG8_WAIT_L(n) asm volatile("s_waitcnt lgkmcnt(" #n ")" ::: "memory")
#define PG8_BAR __builtin_amdgcn_s_barrier()
#define PG8_SCHED __builtin_amdgcn_sched_barrier(0)
    Unit cur, nxt; int ui = 0;
    if (!S.next(0, cur)) return;
    f32x4 acc[2][2][4][2];
#pragma unroll
    for (int a = 0; a < 2; ++a)
#pragma unroll
        for (int b = 0; b < 2; ++b)
#pragma unroll
            for (int m = 0; m < 4; ++m)
#pragma unroll
                for (int n = 0; n < 2; ++n) acc[a][b][m][n] = (f32x4){0.f, 0.f, 0.f, 0.f};
    bf16x8 At[4][2], B0[2][2], B1[2][2];
    const char* cA = cur.A; const char* cB = cur.B;
    PG8_STAGE(PG8_SB(0, 0), cB, voffB); PG8_STAGE(PG8_SB(0, 1), cB + hstepB, voffB); PG8_STAGE(PG8_SA(0, 0), cA, voffA); PG8_STAGE(PG8_SA(0, 1), cA + hstepA, voffA);
    if (wr == 1) PG8_BAR;
    PG8_WAIT_V(2); PG8_BAR;
    PG8_STAGE(PG8_SB(1, 0), cB + kstep, voffB); PG8_STAGE(PG8_SA(1, 0), cA + kstep, voffA); PG8_STAGE(PG8_SB(1, 1), cB + hstepB + kstep, voffB);
    PG8_WAIT_V(6); PG8_BAR;
    for (;;) {
        const bool has_next = S.next(ui + 1, nxt);
        const char* nA = has_next ? nxt.A : cA; const char* nB = has_next ? nxt.B : cB;
#pragma unroll 1
        for (int t = 0; t < nt; t += 2) {
            const bool last = (t == nt - 2);
            const char* a1 = cA + (size_t)(t + 1) * kstep;
            const char* a2 = last ? nA : cA + (size_t)(t + 2) * kstep; const char* b2 = last ? nB : cB + (size_t)(t + 2) * kstep;
            const char* a3 = a2 + kstep; const char* b3 = b2 + kstep;
            PG8_LDB(B0, 0, 0); PG8_LDB(B1, 0, 1); PG8_SCHED; PG8_LDA(At, 0, 0); PG8_STAGE(PG8_SA(1, 1), a1 + hstepA, voffA);
            PG8_WAIT_V(8); PG8_WAIT_L(0); PG8_BAR; PG8_MMA(0, 0, At, B0); PG8_MMA(0, 1, At, B1); PG8_BAR; PG8_SCHED;
            PG8_LDA(At, 0, 1); PG8_STAGE(PG8_SB(0, 0), b2, voffB); PG8_STAGE(PG8_SB(0, 1), b2 + hstepB, voffB); PG8_STAGE(PG8_SA(0, 0), a2, voffA);
            PG8_WAIT_V(8); PG8_WAIT_L(0); PG8_BAR; PG8_MMA(1, 0, At, B0); PG8_MMA(1, 1, At, B1); PG8_BAR; PG8_SCHED;
            PG8_LDB(B0, 1, 0); PG8_LDB(B1, 1, 1); PG8_SCHED; PG8_LDA(At, 1, 0); PG8_STAGE(PG8_SA(0, 1), a2 + hstepA, voffA);
            PG8_WAIT_V(8); PG8_WAIT_L(0); PG8_BAR; PG8_MMA(0, 0, At, B0); PG8_MMA(0, 1, At, B1); PG8_BAR; PG8_SCHED;
            PG8_LDA(At, 1, 1); PG8_STAGE(PG8_SB(1, 0), b3, voffB); PG8_STAGE(PG8_SB(1, 1), b3 + hstepB, voffB); PG8_STAGE(PG8_SA(1, 0), a3, voffA);
            PG8_WAIT_V(8); PG8_WAIT_L(0); PG8_BAR; PG8_MMA(1, 0, At, B0); PG8_MMA(1, 1, At, B1); PG8_BAR; PG8_SCHED;
        }
        if (wr == 0) PG8_BAR;
        E(acc, cur, wr, wc, fr, fq, lx);
        if (!has_next) break;
#pragma unroll
        for (int a = 0; a < 2; ++a)
#pragma unroll
            for (int b = 0; b < 2; ++b)
#pragma unroll
                for (int m = 0; m < 4; ++m)
#pragma unroll
                    for (int n = 0; n < 2; ++n) acc[a][b][m][n] = (f32x4){0.f, 0.f, 0.f, 0.f};
        cur = nxt; cA = nA; cB = nB; ++ui;
        if (wr == 1) PG8_BAR;
    }
    PG8_WAIT_V(0);
    PG8_BAR;
#undef PG8_SA
#undef PG8_SB
#undef PG8_STAGE
#undef PG8_LDA
#undef PG8_LDB
#undef PG8_MMA
#undef PG8_WAIT_V
#undef PG8_WAIT_L
#undef PG8_BAR
#undef PG8_SCHED
}
}
using pg8::Unit; using pg8::GemmP; using pg8::pack8;

namespace attn {
constexpr int AD = 128, NW = 8, QBLK = 32, KVBLK = 64, LD = PC;
constexpr float SCALE = 0.088388347648318440f;
constexpr float THR = 8.f;
constexpr size_t SHM_V = KVBLK * AD * 2, SHM_K = KVBLK * AD * 2, SHM_ATTN = 2 * SHM_V + 2 * SHM_K + NW * 64 * 4;
#define KSWZ(row, colB) ((row) * 256 + ((colB) ^ (((row) & 7) << 4)))
#define SBAR() __builtin_amdgcn_sched_barrier(0)
DI int crow(int r, int hi) { return (r & 3) + 8 * (r >> 2) + 4 * hi; }
DI void partialSM(f32x16& p0, f32x16& p1, float& m_reg, float& mn, float& alpha) {
  constexpr float C = SCALE * 1.4426950408889634f;
  float pmax = p0[0]; for (int r = 1; r < 16; ++r) pmax = fmaxf(pmax, p0[r]); for (int r = 0; r < 16; ++r) pmax = fmaxf(pmax, p1[r]);
  { auto rr = __builtin_amdgcn_permlane32_swap(__float_as_uint(pmax), __float_as_uint(pmax), false, false);
    pmax = fmaxf(__uint_as_float(rr[0]), __uint_as_float(rr[1])); }
  if (__builtin_expect(__all(pmax - m_reg <= THR / SCALE), 1)) { mn = m_reg; alpha = 1.f; }
  else { mn = fmaxf(m_reg, pmax); alpha = __builtin_amdgcn_exp2f((m_reg - mn) * C); m_reg = mn; }
  float mnC = -mn * C;
  for (int r = 0; r < 16; ++r) p0[r] = fmaf(p0[r], C, mnC); for (int r = 0; r < 16; ++r) p1[r] = fmaf(p1[r], C, mnC);
  for (int r = 0; r < 16; ++r) p0[r] = __builtin_amdgcn_exp2f(p0[r]);
}
DI void finishSM(f32x16& p0, f32x16& p1, float alpha, float& l_reg, bf16x8& pa0, bf16x8& pa1, bf16x8& pa2, bf16x8& pa3) {
  for (int r = 0; r < 16; ++r) p1[r] = __builtin_amdgcn_exp2f(p1[r]);
  float ps = 0; for (int r = 0; r < 16; ++r) ps += p0[r]; for (int r = 0; r < 16; ++r) ps += p1[r];
  { auto rr = __builtin_amdgcn_permlane32_swap(__float_as_uint(ps), __float_as_uint(ps), false, false);
    ps = __uint_as_float(rr[0]) + __uint_as_float(rr[1]); }
  l_reg = l_reg * alpha + ps;
#define PK4(P, BASE, OUT) do { unsigned a0 = cvt_pk_bf16(P[BASE + 0], P[BASE + 1]), a1 = cvt_pk_bf16(P[BASE + 2], P[BASE + 3]);   \
    unsigned b0 = cvt_pk_bf16(P[BASE + 4], P[BASE + 5]), b1 = cvt_pk_bf16(P[BASE + 6], P[BASE + 7]);                              \
    auto r0 = __builtin_amdgcn_permlane32_swap(a0, b0, false, false); auto r1 = __builtin_amdgcn_permlane32_swap(a1, b1, false, false); \
    u32x4 w = {r0[0], r1[0], r0[1], r1[1]}; OUT = *reinterpret_cast<bf16x8*>(&w); } while (0)
  PK4(p0, 0, pa0); PK4(p0, 8, pa1); PK4(p1, 0, pa2); PK4(p1, 8, pa3);
#undef PK4
}
DI void qkt(f32x16& p0, f32x16& p1, const bf16_t* Ks, const bf16x8* qr, int r32, int hi) {
  p0 = f32x16{}; p1 = f32x16{};
  for (int d0 = 0; d0 < 8; ++d0) { int cb = (d0 * 16 + hi * 8) * 2;
    bf16x8 b0 = *reinterpret_cast<const bf16x8*>((const char*)Ks + KSWZ(r32, cb));
    bf16x8 b1 = *reinterpret_cast<const bf16x8*>((const char*)Ks + KSWZ(32 + r32, cb));
    p0 = __builtin_amdgcn_mfma_f32_32x32x16_bf16(b0, qr[d0], p0, 0, 0, 0);
    p1 = __builtin_amdgcn_mfma_f32_32x32x16_bf16(b1, qr[d0], p1, 0, 0, 0); }
}
DI int v_st(int k, int c) { const int kk = (k & ~0xC) | ((k & 4) << 1) | ((k & 8) >> 1); return ((kk >> 3) * 4 + (c >> 5)) * 512 + ((kk & 7) * 32 + (c & 31)) * 2; }
DI int v_rd_base(int lane) { return ((lane & 3) << 3) | (((lane >> 2) & 3) << 6) | (((lane >> 4) & 1) << 5) | (((lane >> 5) & 1) << 8); }
constexpr int v_rd_off(int d0, int ks, int half) { return d0 * 512 + ks * 4096 + half * 2048; }
template <int OFF> DI s16x4 tr_read(int vb) {
  s16x4 r; asm volatile("ds_read_b64_tr_b16 %0, %1 offset:%2" : "=&v"(r) : "v"(vb), "i"(OFF) : "memory"); return r;
}
template <int D0> DI void pv_one(f32x16& od, int vb, bf16x8 pa0, bf16x8 pa1, bf16x8 pa2, bf16x8 pa3) {
  const s16x4 l0 = tr_read<v_rd_off(D0, 0, 0)>(vb), h0 = tr_read<v_rd_off(D0, 0, 1)>(vb), l1 = tr_read<v_rd_off(D0, 1, 0)>(vb), h1 = tr_read<v_rd_off(D0, 1, 1)>(vb);
  const s16x4 l2 = tr_read<v_rd_off(D0, 2, 0)>(vb), h2 = tr_read<v_rd_off(D0, 2, 1)>(vb), l3 = tr_read<v_rd_off(D0, 3, 0)>(vb), h3 = tr_read<v_rd_off(D0, 3, 1)>(vb);
  asm volatile("s_waitcnt lgkmcnt(0)" ::: "memory"); SBAR();
#define PK(L, H) (bf16x8){L[0], L[1], L[2], L[3], H[0], H[1], H[2], H[3]}
  od = __builtin_amdgcn_mfma_f32_32x32x16_bf16(pa0, PK(l0, h0), od, 0, 0, 0);
  od = __builtin_amdgcn_mfma_f32_32x32x16_bf16(pa1, PK(l1, h1), od, 0, 0, 0);
  od = __builtin_amdgcn_mfma_f32_32x32x16_bf16(pa2, PK(l2, h2), od, 0, 0, 0);
  od = __builtin_amdgcn_mfma_f32_32x32x16_bf16(pa3, PK(l3, h3), od, 0, 0, 0);
#undef PK
}
DI void pv_d0(f32x16* o, int vb, bf16x8 pa0, bf16x8 pa1, bf16x8 pa2, bf16x8 pa3) {
  pv_one<0>(o[0], vb, pa0, pa1, pa2, pa3); pv_one<1>(o[1], vb, pa0, pa1, pa2, pa3); pv_one<2>(o[2], vb, pa0, pa1, pa2, pa3); pv_one<3>(o[3], vb, pa0, pa1, pa2, pa3);
}
DI void attn_dense_body(int wave_, const bf16_t* __restrict__ Qb, const bf16_t* __restrict__ Kh, const bf16_t* __restrict__ Vh, bf16_t* Ob, int seq, char* lds) {
  const int tid = opaque_tid(wave_), wid = tid >> 6, lane = tid & 63, r32 = lane & 31, hi = lane >> 5;
  bf16_t* V_lds = (bf16_t*)lds; bf16_t* K_lds = (bf16_t*)(lds + 2 * SHM_V);
  float* ws = (float*)(lds + 2 * SHM_V + 2 * SHM_K) + wid * 64; float* li_l = ws; float* al_l = ws + 32;
  float m_reg = -1e30f, l_reg = 0; f32x16 o[4] = {}; bf16x8 qr[8];
  const bf16_t* Qw = Qb + (long)(wid * QBLK + r32) * LD + hi * 8;
#pragma unroll
  for (int d0 = 0; d0 < 8; ++d0) qr[d0] = *reinterpret_cast<const bf16x8*>(Qw + d0 * 16);
  const int sr = tid >> 4, sc = (tid & 15) * 8, vst0 = v_st(sr, sc), vst1 = v_st(32 + sr, sc);
  const int vb0 = (int)(uintptr_t)V_lds + v_rd_base(lane);
  struct { bf16x8 vs0, vs1, ks0, ks1; } sr_[2];
#define SLOAD(i, k0) do { sr_[i].vs0 = *(const bf16x8*)(&Vh[(long)((k0) + sr) * LD + sc]); sr_[i].vs1 = *(const bf16x8*)(&Vh[(long)((k0) + 32 + sr) * LD + sc]); \
    sr_[i].ks0 = *(const bf16x8*)(&Kh[(long)((k0) + sr) * LD + sc]); sr_[i].ks1 = *(const bf16x8*)(&Kh[(long)((k0) + 32 + sr) * LD + sc]); } while (0)
#define SWRITE(b, i) do { *(bf16x8*)((char*)V_lds + (b) * SHM_V + vst0) = sr_[i].vs0;          \
    *(bf16x8*)((char*)V_lds + (b) * SHM_V + vst1) = sr_[i].vs1; int kc = sc * 2;               \
    *(bf16x8*)((char*)K_lds + (b) * SHM_K + KSWZ(sr, kc)) = sr_[i].ks0;                       \
    *(bf16x8*)((char*)K_lds + (b) * SHM_K + KSWZ(32 + sr, kc)) = sr_[i].ks1; } while (0)
#define SWAIT() asm volatile("s_waitcnt vmcnt(4)" ::: "memory")
#define RESC(a) do { if (__any((a) < 1.f)) { if (hi == 0) al_l[r32] = (a); asm volatile("s_waitcnt lgkmcnt(0)" ::: "memory"); \
    for (int d = 0; d < 4; ++d) for (int r = 0; r < 16; ++r) o[d][r] *= al_l[crow(r, hi)]; } } while (0)
  f32x16 pA0, pA1, pB0, pB1; float mnA, mnB, alA, alB; bf16x8 pa0, pa1, pa2, pa3; const int NT = seq / KVBLK;
  constexpr int SE = 0, SO = 1;
  SLOAD(SE, 0); asm volatile("s_waitcnt vmcnt(0)" ::: "memory"); SWRITE(0, SE); __syncthreads();
  qkt(pA0, pA1, K_lds, qr, r32, hi); partialSM(pA0, pA1, m_reg, mnA, alA);
  SLOAD(SO, KVBLK); if (2 < NT) SLOAD(SE, 2 * KVBLK);
  SWAIT(); SWRITE(1, SO); __syncthreads();
  for (int j = 1; j + 1 < NT; j += 2) {
    SBAR(); qkt(pB0, pB1, (bf16_t*)((char*)K_lds + SHM_K), qr, r32, hi);
    finishSM(pA0, pA1, alA, l_reg, pa0, pa1, pa2, pa3); SBAR();
    SLOAD(SO, (j + 2) * KVBLK); SBAR();
    pv_d0(o, vb0, pa0, pa1, pa2, pa3); partialSM(pB0, pB1, m_reg, mnB, alB);
    __syncthreads(); SWAIT(); SWRITE(0, SE);
    RESC(alB); __syncthreads();
    SBAR(); qkt(pA0, pA1, K_lds, qr, r32, hi);
    finishSM(pB0, pB1, alB, l_reg, pa0, pa1, pa2, pa3); SBAR();
    if (j + 3 < NT) SLOAD(SE, (j + 3) * KVBLK); SBAR();
    pv_d0(o, vb0 + (int)SHM_V, pa0, pa1, pa2, pa3); partialSM(pA0, pA1, m_reg, mnA, alA);
    __syncthreads(); SWAIT(); SWRITE(1, SO);
    RESC(alA); __syncthreads();
  }
  SBAR(); qkt(pB0, pB1, (bf16_t*)((char*)K_lds + SHM_K), qr, r32, hi);
  finishSM(pA0, pA1, alA, l_reg, pa0, pa1, pa2, pa3); SBAR();
  pv_d0(o, vb0, pa0, pa1, pa2, pa3); partialSM(pB0, pB1, m_reg, mnB, alB);
  __syncthreads(); RESC(alB);
  finishSM(pB0, pB1, alB, l_reg, pa0, pa1, pa2, pa3); SBAR();
  pv_d0(o, vb0 + (int)SHM_V, pa0, pa1, pa2, pa3);
  if (hi == 0) li_l[r32] = l_reg; asm volatile("s_waitcnt lgkmcnt(0)" ::: "memory");
  float rli[16];
#pragma unroll
  for (int r = 0; r < 16; ++r) rli[r] = __builtin_amdgcn_rcpf(li_l[crow(r, hi)]);
  bf16_t* Ow = Ob + (long)(wid * QBLK) * LD;
#pragma unroll
  for (int r = 0; r < 16; ++r) { int orow = crow(r, hi);
    for (int d0 = 0; d0 < 4; ++d0) Ow[(long)orow * LD + d0 * 32 + r32] = f2bf(o[d0][r] * rli[r]); }
  asm volatile("s_waitcnt vmcnt(0) lgkmcnt(0)" ::: "memory"); __syncthreads();
#undef SLOAD
#undef SWRITE
#undef SWAIT
#undef RESC
}
}

struct Inputs {
    const float *x_prompt, *x_sample, *mem_prompt, *mem_sample, *g_mix_pre, *g_mix_post, *w_in, *hy_conv, *hy_fw1, *hy_fb1, *hy_fw2, *hy_fb2, *hy_fw3, *hy_bias,
                *ret_decay, *att_qnorm, *att_knorm, *w_branch, *w_out, *g_x_pre, *g_x_post, *g_mem, *w_xq, *w_xkv, *w_xo, *g_ff_pre, *g_ff_post, *w_ff1, *w_ff2;
};
struct Args { Inputs in; float* out; unsigned char* ws; int ph_lo, ph_hi; };

DI void transpose_item(const float* W, int K, int N, bf16_t* WT, int item, LAS float* scr, int lane) {
    const int nblk = N / 32, kb = item / nblk, nb = item % nblk, k0 = 64 * kb, n0 = 32 * nb;
    float tv[32];
#pragma unroll
    for (int i = 0; i < 32; ++i) { const int kk = 2 * i + (lane >> 5); tv[i] = __builtin_nontemporal_load(W + (size_t)(k0 + kk) * N + n0 + (lane & 31)); }
#pragma unroll
    for (int i = 0; i < 32; ++i) { const int kk = 2 * i + (lane >> 5); scr[kk * 33 + (lane & 31)] = tv[i]; }
    LDS_WAIT();
    const int c = lane & 7;
#pragma unroll
    for (int j = 0; j < 4; ++j) { const int n = (lane >> 3) + 8 * j; const LAS float* s = scr + (8 * c) * 33 + n;
        u32x4 o; o.x = cvt_pk_bf16(s[0 * 33], s[1 * 33]); o.y = cvt_pk_bf16(s[2 * 33], s[3 * 33]); o.z = cvt_pk_bf16(s[4 * 33], s[5 * 33]); o.w = cvt_pk_bf16(s[6 * 33], s[7 * 33]);
        *(u32x4*)(WT + (size_t)(n0 + n) * K + k0 + 8 * c) = o; }
    LDS_WAIT();
}
DI void convert_weights(const Inputs& in, int l, unsigned char* ws, LAS unsigned char* lds, int gw, int NGW, int wave, int lane) {
    LAS float* scr = (LAS float*)(lds + wave * 16384);
    unsigned char* wb = ws + WS_WB;
    constexpr int I_IN = 16 * 240, I_BR = 8 * 32, I_SQ = 16 * 32, I_KV = 16 * 64, I_F1 = 16 * 128, I_F2 = 64 * 32;
    for (int it = gw; it < I_IN; it += NGW) transpose_item(in.w_in + (size_t)l * 1024 * INC, 1024, INC, (bf16_t*)(wb + WB_IN), it, scr, lane);
    for (int it = gw; it < 3 * I_BR; it += NGW) { const int br = it / I_BR; transpose_item(in.w_branch + (size_t)l * 1536 * 1024 + (size_t)br * 512 * 1024, 512, 1024, (bf16_t*)(wb + WB_BR) + (size_t)br * 1024 * 512, it % I_BR, scr, lane); }
    for (int it = gw; it < I_SQ; it += NGW) transpose_item(in.w_out + (size_t)l * 1024 * 1024, 1024, 1024, (bf16_t*)(wb + WB_OUT), it, scr, lane);
    for (int it = gw; it < I_SQ; it += NGW) transpose_item(in.w_xq + (size_t)l * 1024 * 1024, 1024, 1024, (bf16_t*)(wb + WB_XQ), it, scr, lane);
    for (int it = gw; it < I_KV; it += NGW) transpose_item(in.w_xkv + (size_t)l * 1024 * 2048, 1024, 2048, (bf16_t*)(wb + WB_XKV), it, scr, lane);
    for (int it = gw; it < I_SQ; it += NGW) transpose_item(in.w_xo + (size_t)l * 1024 * 1024, 1024, 1024, (bf16_t*)(wb + WB_XO), it, scr, lane);
    for (int it = gw; it < I_F1; it += NGW) transpose_item(in.w_ff1 + (size_t)l * 1024 * 4096, 1024, 4096, (bf16_t*)(wb + WB_F1), it, scr, lane);
    for (int it = gw; it < I_F2; it += NGW) transpose_item(in.w_ff2 + (size_t)l * 4096 * 1024, 4096, 1024, (bf16_t*)(wb + WB_F2), it, scr, lane);
}

template <bool XIN_BF, bool XOUT_BF>
DI void norm_row(const void* xin, const bf16_t* Rrow, const float* gpost, void* xout, const float* gpre, bf16_t* xn, int lane) {
    f32x4 v[4];
#pragma unroll
    for (int j = 0; j < 4; ++j) {
        if (XIN_BF) { const u32x2 w = *(const u32x2*)((const bf16_t*)xin + 4 * lane + 256 * j); v[j] = (f32x4){bflo(w.x), bfhi(w.x), bflo(w.y), bfhi(w.y)}; }
        else v[j] = *(const f32x4*)((const float*)xin + 4 * lane + 256 * j); }
    if (Rrow) {
        f32x4 r[4]; float ss = 0.f;
#pragma unroll
        for (int j = 0; j < 4; ++j) { const u32x2 w = *(const u32x2*)(Rrow + 4 * lane + 256 * j); r[j] = (f32x4){bflo(w.x), bfhi(w.x), bflo(w.y), bfhi(w.y)};
            ss += (r[j][0] * r[j][0] + r[j][1] * r[j][1]) + (r[j][2] * r[j][2] + r[j][3] * r[j][3]); }
        const float rinv = __builtin_amdgcn_rsqf(wave_sum(ss) * (1.f / 1024.f) + EPS);
#pragma unroll
        for (int j = 0; j < 4; ++j) { const f32x4 g = *(const f32x4*)(gpost + 4 * lane + 256 * j); v[j] += r[j] * rinv * g; }
    }
    if (xout) {
#pragma unroll
        for (int j = 0; j < 4; ++j) {
            if (XOUT_BF) { u32x2 w; w.x = cvt_pk_bf16(v[j][0], v[j][1]); w.y = cvt_pk_bf16(v[j][2], v[j][3]); *(u32x2*)((bf16_t*)xout + 4 * lane + 256 * j) = w;
                           v[j] = (f32x4){bflo(w.x), bfhi(w.x), bflo(w.y), bfhi(w.y)}; }
            else *(f32x4*)((float*)xout + 4 * lane + 256 * j) = v[j]; }
    }
    if (xn) {
        float ss = 0.f;
#pragma unroll
        for (int j = 0; j < 4; ++j) ss += (v[j][0] * v[j][0] + v[j][1] * v[j][1]) + (v[j][2] * v[j][2] + v[j][3] * v[j][3]);
        const float rinv = __builtin_amdgcn_rsqf(wave_sum(ss) * (1.f / 1024.f) + EPS);
#pragma unroll
        for (int j = 0; j < 4; ++j) { const f32x4 g = *(const f32x4*)(gpre + 4 * lane + 256 * j); const f32x4 o = v[j] * rinv * g;
            u32x2 w; w.x = cvt_pk_bf16(o[0], o[1]); w.y = cvt_pk_bf16(o[2], o[3]); *(u32x2*)(xn + 4 * lane + 256 * j) = w; }
    }
}

template <bool XOUT_BF, int NR>
DI void norm_rows(const bf16_t* xin, const bf16_t* Rb, const float* gpost, void* xout, const float* gpre, bf16_t* xnb, size_t row0, size_t rstride, int lane) {
    f32x4 v[NR][4], r[NR][4];
#pragma unroll
    for (int q = 0; q < NR; ++q)
#pragma unroll
        for (int j = 0; j < 4; ++j) { const size_t off = (row0 + q * rstride) * D + 4 * lane + 256 * j;
            const u32x2 w = __builtin_nontemporal_load((const u32x2*)(xin + off)); v[q][j] = (f32x4){bflo(w.x), bfhi(w.x), bflo(w.y), bfhi(w.y)};
            const u32x2 w2 = __builtin_nontemporal_load((const u32x2*)(Rb + off)); r[q][j] = (f32x4){bflo(w2.x), bfhi(w2.x), bflo(w2.y), bfhi(w2.y)}; }
    float ss[NR], s2[NR];
#pragma unroll
    for (int q = 0; q < NR; ++q) { ss[q] = 0.f; s2[q] = 0.f;
#pragma unroll
        for (int j = 0; j < 4; ++j) ss[q] += (r[q][j][0] * r[q][j][0] + r[q][j][1] * r[q][j][1]) + (r[q][j][2] * r[q][j][2] + r[q][j][3] * r[q][j][3]); }
#pragma unroll
    for (int o = 1; o < 64; o <<= 1)
#pragma unroll
        for (int q = 0; q < NR; ++q) ss[q] += __shfl_xor(ss[q], o);
#pragma unroll
    for (int q = 0; q < NR; ++q) { const float rinv = __builtin_amdgcn_rsqf(ss[q] * (1.f / 1024.f) + EPS);
#pragma unroll
        for (int j = 0; j < 4; ++j) { const size_t off = (row0 + q * rstride) * D + 4 * lane + 256 * j;
            const f32x4 g = *(const f32x4*)(gpost + 4 * lane + 256 * j); v[q][j] += r[q][j] * rinv * g;
            if (XOUT_BF) { u32x2 w; w.x = cvt_pk_bf16(v[q][j][0], v[q][j][1]); w.y = cvt_pk_bf16(v[q][j][2], v[q][j][3]); *(u32x2*)((bf16_t*)xout + off) = w;
                           v[q][j] = (f32x4){bflo(w.x), bfhi(w.x), bflo(w.y), bfhi(w.y)}; }
            else *(f32x4*)((float*)xout + off) = v[q][j];
            s2[q] += (v[q][j][0] * v[q][j][0] + v[q][j][1] * v[q][j][1]) + (v[q][j][2] * v[q][j][2] + v[q][j][3] * v[q][j][3]); } }
    if (xnb) {
#pragma unroll
        for (int o = 1; o < 64; o <<= 1)
#pragma unroll
            for (int q = 0; q < NR; ++q) s2[q] += __shfl_xor(s2[q], o);
#pragma unroll
        for (int q = 0; q < NR; ++q) { const float rinv = __builtin_amdgcn_rsqf(s2[q] * (1.f / 1024.f) + EPS);
#pragma unroll
            for (int j = 0; j < 4; ++j) { const size_t off = (row0 + q * rstride) * D + 4 * lane + 256 * j;
                const f32x4 g = *(const f32x4*)(gpre + 4 * lane + 256 * j); const f32x4 o = v[q][j] * rinv * g;
                u32x2 w; w.x = cvt_pk_bf16(o[0], o[1]); w.y = cvt_pk_bf16(o[2], o[3]); *(u32x2*)(xnb + off) = w; } }
    }
}

DI void make_tables(unsigned char* ws, int gtid, int NT) {
    float* rtc = (float*)(ws + WS_RTC); float* rts = (float*)(ws + WS_RTS); float* axc = (float*)(ws + WS_AXC); float* axs = (float*)(ws + WS_AXS);
    const double TWO_PI = 6.283185307179586476925286766559;
    for (int i = gtid; i < 4096 * 64 + 64 * 32; i += NT) {
        int pos, fi; double inv;
        if (i < 4096 * 64) { pos = i >> 6; fi = i & 63; inv = exp(-9.210340371976182736 * (double)fi / 64.0); }
        else { const int j = i - 4096 * 64; pos = j >> 5; fi = j & 31; inv = exp(-9.210340371976182736 * (double)fi / 32.0); }
        const double ang = (double)pos * inv; const double red = ang - TWO_PI * rint(ang / TWO_PI);
        const float c = __cosf((float)red), s = __sinf((float)red);
        if (i < 4096 * 64) { rtc[i] = c; rts[i] = s; } else { axc[i - 4096 * 64] = c; axs[i - 4096 * 64] = s; }
    }
}

DI void filter_gen(const Inputs& in, int l, unsigned char* ws, LAS unsigned char* lds, int vcu, int G, int wave, int tid) {
    const float* w1 = in.hy_fw1 + (size_t)l * 33 * 64; const float* b1 = in.hy_fb1 + l * 64; const float* w2 = in.hy_fw2 + (size_t)l * 64 * 64; const float* b2 = in.hy_fb2 + l * 64;
    const float* w3 = in.hy_fw3 + (size_t)l * 64 * 1024;
    const int lane = tid & 63, chunk = vcu & 3, wgi = vcu >> 2, nwg = (G + 3 - chunk) >> 2;
    LAS float* W3s = (LAS float*)lds; LAS float* W1s = (LAS float*)(lds + 65536); LAS float* W2s = (LAS float*)(lds + 65536 + 8448); LAS float* Bs = (LAS float*)(lds + 65536 + 8448 + 16384);
    __syncthreads();
    { f32x4 t3[8];
#pragma unroll
      for (int k = 0; k < 8; ++k) { const int i = tid + 512 * k; t3[k] = *(const f32x4*)(w3 + (i >> 6) * 1024 + 256 * chunk + (i & 63) * 4); }
      f32x4 t2[2], t1[2];
#pragma unroll
      for (int k = 0; k < 2; ++k) { const int i = tid + 512 * k; t2[k] = *(const f32x4*)(w2 + i * 4); t1[k] = i < 528 ? *(const f32x4*)(w1 + i * 4) : (f32x4){0.f, 0.f, 0.f, 0.f}; }
#pragma unroll
      for (int k = 0; k < 8; ++k) { const int i = tid + 512 * k; *(LAS f32x4*)(W3s + (i >> 6) * 256 + (i & 63) * 4) = t3[k]; }
#pragma unroll
      for (int k = 0; k < 2; ++k) { const int i = tid + 512 * k; *(LAS f32x4*)(W2s + i * 4) = t2[k]; if (i < 528) *(LAS f32x4*)(W1s + i * 4) = t1[k]; } }
    if (tid < 64) Bs[tid] = b1[tid]; else if (tid < 128) Bs[tid] = b2[tid - 64];
    __syncthreads();
    for (int it = wgi * 8 + wave; it < 4096 + 2048; it += nwg * 8) {
        const int g = it >= 4096, t = g ? it - 4096 : it, L = g ? 2048 : 4096, FRS = g ? FRS1 : FRS0;
        bf16_t* FR = (bf16_t*)(ws + (g ? WS_FR1 : WS_FR0)); bf16_t* FRO = (bf16_t*)(ws + (g ? WS_FRO1 : WS_FRO0));
        const float tl = (float)t / (float)(L - 1);
        const float w = 6.2831853071795864769f * (float)t / (float)L;
        float z;
        { const int k = lane; const int fi = (k >= 17) ? k - 17 : k - 1; const float f = 1e-4f + (float)fi * ((15.0f - 1e-4f) / 15.0f);
          z = (k == 0) ? tl : (k <= 16 ? __cosf(f * w) : -__sinf(f * w)); if (k > 32) z = 0.f; }
        float a = Bs[lane];
#pragma unroll 11
        for (int k = 0; k < 33; ++k) a += __shfl(z, k) * W1s[k * 64 + lane];
        const float h1 = __sinf(a);
        a = Bs[64 + lane];
#pragma unroll 16
        for (int k = 0; k < 64; ++k) a += __shfl(h1, k) * W2s[k * 64 + lane];
        const float h2 = __sinf(a);
        float o[4] = {0.f, 0.f, 0.f, 0.f};
#pragma unroll 16
        for (int k = 0; k < 64; ++k) { const float hk = __shfl(h2, k);
#pragma unroll
            for (int q = 0; q < 4; ++q) o[q] += hk * W3s[k * 256 + lane + 64 * q]; }
#pragma unroll
        for (int q = 0; q < 4; ++q) {
            const int cidx = 256 * chunk + lane + 64 * q, dir = cidx >> 9, c = cidx & 511;
            const float delta = fabsf(-3.0701134573253942f + (float)c * ((-15.350567286626972f + 3.0701134573253942f) / 511.0f));
            const float val = o[q] * __expf(-tl * delta);
            bf16_t* row = FR + (size_t)c * FRS; bf16_t* rowo = FRO + (size_t)c * FRS;
            if (dir == 0) { row[L - t] = f2bf(val); rowo[L - t - 1] = f2bf(val); }
            else if (t >= 1) { row[L + t] = f2bf(val); rowo[L + t - 1] = f2bf(val); }
        }
    }
    __syncthreads();
}

DI void prep_attn(const Inputs& in, int l, unsigned char* ws, int half, int gw, int NGW, int lane) {
    constexpr int NTK = 4;
    bf16_t* proj = (bf16_t*)(ws + WS_PROJ); const float* axc = (const float*)(ws + WS_AXC); const float* axs = (const float*)(ws + WS_AXS);
    const int L = half ? 2048 : 4096;
    const int d1 = lane < 32 ? lane : 64 + (lane - 32), d2 = d1 + 32, fi = lane & 31;
    const float gq1 = in.att_qnorm[l * 128 + d1], gq2 = in.att_qnorm[l * 128 + d2], gk1 = in.att_knorm[l * 128 + d1], gk2 = in.att_knorm[l * 128 + d2];
    for (int tok0 = gw; tok0 < HT; tok0 += NTK * NGW) {
        float x1[NTK][6], x2[NTK][6], c[NTK], sn[NTK];
#pragma unroll
        for (int k = 0; k < NTK; ++k) { const int tok = tok0 + k * NGW < HT ? tok0 + k * NGW : tok0, t = tok % L; const int pos = lane < 32 ? (t >> 6) : (t & 63);
            c[k] = axc[pos * 32 + fi]; sn[k] = axs[pos * 32 + fi];
            const bf16_t* row = proj + (size_t)tok * PC;
#pragma unroll
            for (int v = 0; v < 6; ++v) { const int base = v < 4 ? C_AQ + 128 * v : C_AK + 128 * (v - 4); x1[k][v] = bf2f(row[base + d1]); x2[k][v] = bf2f(row[base + d2]); } }
        float ss[NTK][6];
#pragma unroll
        for (int k = 0; k < NTK; ++k)
#pragma unroll
            for (int v = 0; v < 6; ++v) ss[k][v] = x1[k][v] * x1[k][v] + x2[k][v] * x2[k][v];
#pragma unroll
        for (int o = 1; o < 64; o <<= 1)
#pragma unroll
            for (int k = 0; k < NTK; ++k)
#pragma unroll
                for (int v = 0; v < 6; ++v) ss[k][v] += __shfl_xor(ss[k][v], o);
#pragma unroll
        for (int k = 0; k < NTK; ++k) { if (tok0 + k * NGW < HT) { bf16_t* row = proj + (size_t)(tok0 + k * NGW) * PC;
#pragma unroll
            for (int v = 0; v < 6; ++v) { const int base = v < 4 ? C_AQ + 128 * v : C_AK + 128 * (v - 4);
                const float rinv = __builtin_amdgcn_rsqf(ss[k][v] * (1.f / 128.f) + EPS);
                const float y1 = x1[k][v] * rinv * (v < 4 ? gq1 : gk1), y2 = x2[k][v] * rinv * (v < 4 ? gq2 : gk2);
                row[base + d1] = f2bf(y1 * c[k] - y2 * sn[k]); row[base + d2] = f2bf(y1 * sn[k] + y2 * c[k]); } } }
    }
}

DI void prep_hyena(const Inputs& in, int l, unsigned char* ws, int half, int vcu, int G, int tid) {
    const bf16_t* proj = (const bf16_t*)(ws + WS_PROJ); bf16_t* ZT = (bf16_t*)(ws + WS_ZT); bf16_t* X0T = (bf16_t*)(ws + WS_X0T);
    const int L = half ? 2048 : 4096, ntb = L / 64;
    const float* cw = in.hy_conv + (size_t)l * 3 * 1536;
    const int cch = tid & 127, tq = tid >> 7, c0 = 4 * cch;
    f32x4 w[3][3];
#pragma unroll
    for (int j = 0; j < 3; ++j)
#pragma unroll
        for (int sg = 0; sg < 3; ++sg) w[j][sg] = *(const f32x4*)(cw + j * 1536 + sg * 512 + c0);
    for (int tile = vcu; tile < HT / 64; tile += G) {
        const int s = tile / ntb, tb = tile % ntb;
        const bf16_t* base = proj + (size_t)(s * L) * PC + c0;
#pragma unroll 1
        for (int hb = 0; hb < 2; ++hb) {
            const int t0 = tb * 64 + (tq + 4 * hb) * 8;
            u32x2 rw[10][3];
#pragma unroll
            for (int r = 0; r < 10; ++r)
#pragma unroll
                for (int sg = 0; sg < 3; ++sg) { const int t = t0 - 1 + r; rw[r][sg] = (u32x2){0u, 0u}; if (t >= 0 && t < L) rw[r][sg] = *(const u32x2*)(base + (size_t)t * PC + sg * 512); }
            unsigned zt[4][4], xt[4][4];
            f32x4 zprev, xprev;
#pragma unroll
            for (int k = 0; k < 8; ++k) {
                f32x4 u[3];
#pragma unroll
                for (int sg = 0; sg < 3; ++sg) { const u32x2 pv = rw[k][sg], cu = rw[k + 1][sg], nx = rw[k + 2][sg];
                    const f32x4 a = {bflo(pv.x), bfhi(pv.x), bflo(pv.y), bfhi(pv.y)}, b = {bflo(cu.x), bfhi(cu.x), bflo(cu.y), bfhi(cu.y)}, c = {bflo(nx.x), bfhi(nx.x), bflo(nx.y), bfhi(nx.y)};
                    u[sg] = a * w[0][sg] + b * w[1][sg] + c * w[2][sg]; }
                const f32x4 z = u[2] * u[1], x = u[0];
                if (k & 1) {
#pragma unroll
                    for (int e = 0; e < 4; ++e) { zt[e][k >> 1] = cvt_pk_bf16(zprev[e], z[e]); xt[e][k >> 1] = cvt_pk_bf16(xprev[e], x[e]); } }
                else { zprev = z; xprev = x; }
            }
#pragma unroll
            for (int e = 0; e < 4; ++e) { const size_t off = (size_t)(s * 512 + c0 + e) * L + t0;
                *(u32x4*)(ZT + off) = (u32x4){zt[e][0], zt[e][1], zt[e][2], zt[e][3]}; *(u32x4*)(X0T + off) = (u32x4){xt[e][0], xt[e][1], xt[e][2], xt[e][3]}; }
        }
    }
}
DI void post_hyena(unsigned char* ws, int half, LAS unsigned char* lds, int vcu, int G, int tid) {
    bf16_t* proj = (bf16_t*)(ws + WS_PROJ); const bf16_t* YT = (const bf16_t*)(ws + WS_X0T);
    const int L = half ? 2048 : 4096, ntb = L / 64;
    LAS bf16_t* Ts = (LAS bf16_t*)lds;
    for (int tile = vcu; tile < (HT / 64) * 8; tile += G) {
        const int cb = tile & 7, tbg = tile >> 3, s = tbg / ntb, tb = tbg % ntb;
        { const int c2 = tid >> 3, ch = tid & 7; *(LAS u32x4*)(Ts + c2 * 72 + 8 * ch) = *(const u32x4*)(YT + (size_t)(s * 512 + cb * 64 + c2) * L + tb * 64 + 8 * ch); }
        __syncthreads();
        { const int t2 = tid >> 3, ch = tid & 7; unsigned short e[8];
#pragma unroll
          for (int k = 0; k < 8; ++k) e[k] = Ts[(8 * ch + k) * 72 + t2];
          u32x4 o; o.x = e[0] | ((unsigned)e[1] << 16); o.y = e[2] | ((unsigned)e[3] << 16); o.z = e[4] | ((unsigned)e[5] << 16); o.w = e[6] | ((unsigned)e[7] << 16);
          *(u32x4*)(proj + (size_t)(s * L + tb * 64 + t2) * PC + C_YH + cb * 64 + 8 * ch) = o; }
        __syncthreads();
    }
}

DI void hyena_unit(const Inputs& in, int l, unsigned char* ws, int half, int c, LAS unsigned char* lds, int tid) {
    const int L = half ? 2048 : 4096, NB = half ? 8 : 4, nblk = L / 32, FRS = half ? FRS1 : FRS0, ZS = L + 2048, ZSP = (ZS / 32) * 40;
    const bf16_t* FR = (const bf16_t*)(ws + (half ? WS_FR1 : WS_FR0)) + (size_t)c * FRS; const bf16_t* FRO = (const bf16_t*)(ws + (half ? WS_FRO1 : WS_FRO0)) + (size_t)c * FRS;
    const bf16_t* ZT = (const bf16_t*)(ws + WS_ZT); bf16_t* XT = (bf16_t*)(ws + WS_X0T);
    constexpr int FRB = 16640;
    LAS unsigned char* Zl = lds + 2 * FRB;
    const int cpr = ZS / 8, nfr = (2 * L + 64) / 8;
    { u32x4 fv[5], zv[8];
#pragma unroll
      for (int k = 0; k < 5; ++k) { const int i = tid + 512 * k, cp = i >= nfr, kk = cp ? i - nfr : i; fv[k] = (u32x4){0u, 0u, 0u, 0u};
          if (i < 2 * nfr && kk < 2 * L / 8) fv[k] = *(const u32x4*)((cp ? FRO : FR) + kk * 8);
          if (cp && kk == 2 * L / 8 - 1) fv[k].w &= 0xffffu; }
#pragma unroll
      for (int k = 0; k < 8; ++k) { const int i = tid + 512 * k, b = i / cpr, j = i % cpr, m = j * 8 - 1024; zv[k] = (u32x4){0u, 0u, 0u, 0u};
          if (i < NB * cpr && m >= 0 && m < L) zv[k] = *(const u32x4*)(ZT + (size_t)(b * 512 + c) * L + m); }
#pragma unroll
      for (int k = 0; k < 5; ++k) { const int i = tid + 512 * k, cp = i >= nfr, kk = cp ? i - nfr : i; if (i < 2 * nfr) *(LAS u32x4*)(lds + cp * FRB + kk * 16) = fv[k]; }
#pragma unroll
      for (int k = 0; k < 8; ++k) { const int i = tid + 512 * k, b = i / cpr, j = i % cpr; if (i < NB * cpr) *(LAS u32x4*)(Zl + ((size_t)b * ZSP + (j >> 2) * 40 + (j & 3) * 8) * 2) = zv[k]; } }
    __syncthreads();
    const int wave = tid >> 6, lane = tid & 63, i32 = lane & 31, g = lane >> 5;
    const int gpb = nblk / 32, a0 = 32 * (wave % gpb), b0 = 2 * (wave / gpb);
    const int dlo = a0 - nblk + 1, dhi = a0 + 31;
    f32x16 acc0 = {}, acc1 = {};
    const LAS unsigned char* Zb = Zl + (size_t)b0 * ZSP * 2;
    const int zstep = ZSP * 2;
    int s0 = L - 32 * dlo - i32 + 8 * g;
    const LAS unsigned char* zp0 = Zb + ((32 + a0 + i32 - dlo) * 40 + 8 * g) * 2;
#define HY_A(jh) ({ const int s_ = s0 + 16 * (jh); const LAS unsigned* p_ = (const LAS unsigned*)(lds + (s_ & 1) * FRB) + (s_ >> 1); \
        u32x4 aw_; aw_.x = p_[0]; aw_.y = p_[1]; aw_.z = p_[2]; aw_.w = p_[3]; __builtin_bit_cast(bf16x8, aw_); })
#define HY_B(gi, jh) (*(const LAS bf16x8*)(zp0 + (gi) * zstep + (jh) * 32))
    for (int d = dlo; d <= dhi; ++d) {
#pragma unroll
        for (int jh = 0; jh < 2; ++jh) { const bf16x8 a = HY_A(jh);
            acc0 = __builtin_amdgcn_mfma_f32_32x32x16_bf16(a, HY_B(0, jh), acc0, 0, 0, 0);
            acc1 = __builtin_amdgcn_mfma_f32_32x32x16_bf16(a, HY_B(1, jh), acc1, 0, 0, 0); }
        s0 -= 32; zp0 -= 80;
    }
#undef HY_A
#undef HY_B
    const float bias = in.hy_bias[l * 512 + c];
    u32x2 xx[2][4];
#pragma unroll
    for (int k = 0; k < 2; ++k)
#pragma unroll
        for (int q = 0; q < 4; ++q) xx[k][q] = *(const u32x2*)(XT + (size_t)((b0 + k) * 512 + c) * L + 32 * (a0 + i32) + 8 * q + 4 * g);
#pragma unroll
    for (int k = 0; k < 2; ++k) {
        const int a = a0 + i32, b = b0 + k;
#pragma unroll
        for (int q = 0; q < 4; ++q) {
            const int t0 = 32 * a + 8 * q + 4 * g;
            const u32x2 zz = *(const LAS u32x2*)(Zb + k * zstep + ((32 + a) * 40 + 8 * q + 4 * g) * 2);
            bf16_t* xp = XT + (size_t)(b * 512 + c) * L + t0;
            const float z0 = bflo(zz.x), z1 = bfhi(zz.x), z2 = bflo(zz.y), z3 = bfhi(zz.y);
            const float x0 = bflo(xx[k][q].x), x1 = bfhi(xx[k][q].x), x2 = bflo(xx[k][q].y), x3 = bfhi(xx[k][q].y);
            const float c0 = k ? acc1[4 * q + 0] : acc0[4 * q + 0], c1 = k ? acc1[4 * q + 1] : acc0[4 * q + 1], c2 = k ? acc1[4 * q + 2] : acc0[4 * q + 2], c3 = k ? acc1[4 * q + 3] : acc0[4 * q + 3];
            u32x2 o; o.x = cvt_pk_bf16((c0 + z0 * bias) * x0, (c1 + z1 * bias) * x1); o.y = cvt_pk_bf16((c2 + z2 * bias) * x2, (c3 + z3 * bias) * x3);
            *(u32x2*)xp = o;
        }
    }
    __syncthreads();
}

namespace ret {
constexpr int TS = 136, TILE_B = 128 * TS * 2;
DI float logsig(float x) { return -log1pf(__expf(-x)); }
DI void unpack8(const u32x4 w, float (&f)[8]) { f[0] = bflo(w.x); f[1] = bfhi(w.x); f[2] = bflo(w.y); f[3] = bfhi(w.y); f[4] = bflo(w.z); f[5] = bfhi(w.z); f[6] = bflo(w.w); f[7] = bfhi(w.w); }
DI int sw(int row, int col) { return row * TS + ((((col >> 3) ^ (row >> 3)) & 15) << 3) + (col & 7); }
DI void rot_item(const bf16_t* src, const float* rtc, const float* rts, int pos0, int j, int d0, float (&o1)[8], float (&o2)[8]) {
    float x1[8], x2[8]; unpack8(*(const u32x4*)(src + (size_t)j * PC + d0), x1); unpack8(*(const u32x4*)(src + (size_t)j * PC + 64 + d0), x2);
    const float* cp = rtc + (size_t)(pos0 + j) * 64 + d0; const float* sp = rts + (size_t)(pos0 + j) * 64 + d0;
    const f32x4 ca = *(const f32x4*)cp, cb = *(const f32x4*)(cp + 4), sa = *(const f32x4*)sp, sb = *(const f32x4*)(sp + 4);
#pragma unroll
    for (int e = 0; e < 8; ++e) { const float c = e < 4 ? ca[e & 3] : cb[e & 3], s = e < 4 ? sa[e & 3] : sb[e & 3]; o1[e] = x1[e] * c - x2[e] * s; o2[e] = x1[e] * s + x2[e] * c; }
}
DI void stage_rot_rm(LAS unsigned char* dst, const bf16_t* src, const float* rtc, const float* rts, int pos0, float scale, int tid) {
    for (int it = tid; it < 1024; it += 512) { const int j = it >> 3, d0 = (it & 7) * 8; float o1[8], o2[8]; rot_item(src, rtc, rts, pos0, j, d0, o1, o2);
        u32x4 w1, w2; w1.x = cvt_pk_bf16(o1[0] * scale, o1[1] * scale); w1.y = cvt_pk_bf16(o1[2] * scale, o1[3] * scale); w1.z = cvt_pk_bf16(o1[4] * scale, o1[5] * scale); w1.w = cvt_pk_bf16(o1[6] * scale, o1[7] * scale);
        w2.x = cvt_pk_bf16(o2[0] * scale, o2[1] * scale); w2.y = cvt_pk_bf16(o2[2] * scale, o2[3] * scale); w2.z = cvt_pk_bf16(o2[4] * scale, o2[5] * scale); w2.w = cvt_pk_bf16(o2[6] * scale, o2[7] * scale);
        *(LAS u32x4*)(dst + sw(j, d0) * 2) = w1; *(LAS u32x4*)(dst + sw(j, 64 + d0) * 2) = w2; }
}
DI void stage_rot_T2(LAS unsigned char* dF, LAS unsigned char* dB, const bf16_t* src, const float* rtc, const float* rts, int pos0, float scale, float lgf, float lgb, int tid) {
    LAS bf16_t* F = (LAS bf16_t*)dF; LAS bf16_t* B = (LAS bf16_t*)dB;
    for (int it = tid; it < 1024; it += 512) { const int j = it >> 3, d0 = (it & 7) * 8; float o1[8], o2[8]; rot_item(src, rtc, rts, pos0, j, d0, o1, o2);
        const float wf = __expf((float)(127 - j) * lgf) * scale, wb = __expf((float)j * lgb) * scale;
#pragma unroll
        for (int e = 0; e < 8; ++e) { const int i1 = sw(d0 + e, j), i2 = sw(64 + d0 + e, j); F[i1] = f2bf(o1[e] * wf); F[i2] = f2bf(o2[e] * wf); B[i1] = f2bf(o1[e] * wb); B[i2] = f2bf(o2[e] * wb); } }
}
struct RotIn { u32x4 a, b; f32x4 ca, cb, sa, sb; };
DI RotIn rot_load(const bf16_t* src, const float* rtc, const float* rts, int pos0, int j, int d0) {
    RotIn r; r.a = *(const u32x4*)(src + (size_t)j * PC + d0); r.b = *(const u32x4*)(src + (size_t)j * PC + 64 + d0);
    const float* cp = rtc + (size_t)(pos0 + j) * 64 + d0; const float* sp = rts + (size_t)(pos0 + j) * 64 + d0;
    r.ca = *(const f32x4*)cp; r.cb = *(const f32x4*)(cp + 4); r.sa = *(const f32x4*)sp; r.sb = *(const f32x4*)(sp + 4); return r;
}
DI void rot_apply(const RotIn& r, float (&o1)[8], float (&o2)[8]) {
    float x1[8], x2[8]; unpack8(r.a, x1); unpack8(r.b, x2);
#pragma unroll
    for (int e = 0; e < 8; ++e) { const float c = e < 4 ? r.ca[e & 3] : r.cb[e & 3], s = e < 4 ? r.sa[e & 3] : r.sb[e & 3]; o1[e] = x1[e] * c - x2[e] * s; o2[e] = x1[e] * s + x2[e] * c; }
}
DI void stage_rot_rm_b(LAS unsigned char* dst, const bf16_t* src, const float* rtc, const float* rts, int pos0, float scale, int tid) {
    const RotIn r0 = rot_load(src, rtc, rts, pos0, tid >> 3, (tid & 7) * 8), r1 = rot_load(src, rtc, rts, pos0, 64 + (tid >> 3), (tid & 7) * 8);
#pragma unroll
    for (int k = 0; k < 2; ++k) { const int j = 64 * k + (tid >> 3), d0 = (tid & 7) * 8; float o1[8], o2[8]; rot_apply(k ? r1 : r0, o1, o2);
        u32x4 w1, w2; w1.x = cvt_pk_bf16(o1[0] * scale, o1[1] * scale); w1.y = cvt_pk_bf16(o1[2] * scale, o1[3] * scale); w1.z = cvt_pk_bf16(o1[4] * scale, o1[5] * scale); w1.w = cvt_pk_bf16(o1[6] * scale, o1[7] * scale);
        w2.x = cvt_pk_bf16(o2[0] * scale, o2[1] * scale); w2.y = cvt_pk_bf16(o2[2] * scale, o2[3] * scale); w2.z = cvt_pk_bf16(o2[4] * scale, o2[5] * scale); w2.w = cvt_pk_bf16(o2[6] * scale, o2[7] * scale);
        *(LAS u32x4*)(dst + sw(j, d0) * 2) = w1; *(LAS u32x4*)(dst + sw(j, 64 + d0) * 2) = w2; }
}
DI void stage_rot_T2_b(LAS unsigned char* dF, LAS unsigned char* dB, const bf16_t* src, const float* rtc, const float* rts, int pos0, float scale, float lgf, float lgb, int tid) {
    LAS bf16_t* F = (LAS bf16_t*)dF; LAS bf16_t* B = (LAS bf16_t*)dB;
    const RotIn r0 = rot_load(src, rtc, rts, pos0, tid >> 3, (tid & 7) * 8), r1 = rot_load(src, rtc, rts, pos0, 64 + (tid >> 3), (tid & 7) * 8);
#pragma unroll
    for (int k = 0; k < 2; ++k) { const int j = 64 * k + (tid >> 3), d0 = (tid & 7) * 8; float o1[8], o2[8]; rot_apply(k ? r1 : r0, o1, o2);
        const float wf = __expf((float)(127 - j) * lgf) * scale, wb = __expf((float)j * lgb) * scale;
#pragma unroll
        for (int e = 0; e < 8; ++e) { const int i1 = sw(d0 + e, j), i2 = sw(64 + d0 + e, j); F[i1] = f2bf(o1[e] * wf); F[i2] = f2bf(o2[e] * wf); B[i1] = f2bf(o1[e] * wb); B[i2] = f2bf(o2[e] * wb); } }
}
DI void stage_T(LAS unsigned char* dst, const bf16_t* src, int tid) {
    LAS bf16_t* T = (LAS bf16_t*)dst;
    for (int it = tid; it < 2048; it += 512) { const int j = it >> 4, c0 = (it & 15) * 8; const u32x4 w = *(const u32x4*)(src + (size_t)j * PC + c0);
        T[sw(c0 + 0, j)] = (bf16_t)(w.x & 0xffff); T[sw(c0 + 1, j)] = (bf16_t)(w.x >> 16); T[sw(c0 + 2, j)] = (bf16_t)(w.y & 0xffff); T[sw(c0 + 3, j)] = (bf16_t)(w.y >> 16);
        T[sw(c0 + 4, j)] = (bf16_t)(w.z & 0xffff); T[sw(c0 + 5, j)] = (bf16_t)(w.z >> 16); T[sw(c0 + 6, j)] = (bf16_t)(w.w & 0xffff); T[sw(c0 + 7, j)] = (bf16_t)(w.w >> 16); }
}
DI void stage_T_b(LAS unsigned char* dst, const bf16_t* src, int tid) {
    LAS bf16_t* T = (LAS bf16_t*)dst;
    u32x4 wv[4];
#pragma unroll
    for (int k = 0; k < 4; ++k) { const int it = tid + 512 * k, j = it >> 4, c0 = (it & 15) * 8; wv[k] = *(const u32x4*)(src + (size_t)j * PC + c0); }
#pragma unroll
    for (int k = 0; k < 4; ++k) { const int it = tid + 512 * k, j = it >> 4, c0 = (it & 15) * 8; const u32x4 w = wv[k];
        T[sw(c0 + 0, j)] = (bf16_t)(w.x & 0xffff); T[sw(c0 + 1, j)] = (bf16_t)(w.x >> 16); T[sw(c0 + 2, j)] = (bf16_t)(w.y & 0xffff); T[sw(c0 + 3, j)] = (bf16_t)(w.y >> 16);
        T[sw(c0 + 4, j)] = (bf16_t)(w.z & 0xffff); T[sw(c0 + 5, j)] = (bf16_t)(w.z >> 16); T[sw(c0 + 6, j)] = (bf16_t)(w.w & 0xffff); T[sw(c0 + 7, j)] = (bf16_t)(w.w >> 16); }
}
DI void stage_state(LAS unsigned char* dst, const bf16_t* src, int tid) {
    u32x4 wv[4];
#pragma unroll
    for (int k = 0; k < 4; ++k) { const int it = tid + 512 * k, e = it >> 4, d0 = (it & 15) * 8; wv[k] = *(const u32x4*)(src + e * 128 + d0); }
#pragma unroll
    for (int k = 0; k < 4; ++k) { const int it = tid + 512 * k, e = it >> 4, d0 = (it & 15) * 8; *(LAS u32x4*)(dst + sw(e, d0) * 2) = wv[k]; }
}
DI void mma16(f32x4 (&acc)[8], const LAS unsigned char* At, int arow0, const LAS unsigned char* Bt, int lane) {
    const int l15 = lane & 15, quad = lane >> 4;
#pragma unroll
    for (int ks = 0; ks < 4; ++ks) {
        const bf16x8 a = *(const LAS bf16x8*)(At + sw(arow0 + l15, 32 * ks + 8 * quad) * 2);
#pragma unroll
        for (int cg = 0; cg < 8; ++cg) { const bf16x8 b = *(const LAS bf16x8*)(Bt + sw(16 * cg + l15, 32 * ks + 8 * quad) * 2);
            acc[cg] = __builtin_amdgcn_mfma_f32_16x16x32_bf16(a, b, acc[cg], 0, 0, 0); }
    }
}
DI void zero8(f32x4 (&a)[8]) {
#pragma unroll
    for (int i = 0; i < 8; ++i) a[i] = (f32x4){0.f, 0.f, 0.f, 0.f};
}
DI void kv_unit(const Inputs& in, int l, unsigned char* ws, int half, int u, LAS unsigned char* lds, int tid) {
    asm volatile("" : "+v"(tid));
    const int L = half ? 2048 : 4096, NC = L / 128, h = u & 3, sn = u >> 2, s = sn / NC, n = sn % NC, row0 = s * L + n * 128, pos0 = n * 128;
    const bf16_t* proj = (const bf16_t*)(ws + WS_PROJ); const float* rtc = (const float*)(ws + WS_RTC); const float* rts = (const float*)(ws + WS_RTS);
    bf16_t* KV = (bf16_t*)(ws + WS_KV);
    const float lgf = logsig(in.ret_decay[l * 8 + h]), lgb = logsig(in.ret_decay[l * 8 + 4 + h]);
    LAS unsigned char* VTt = lds; LAS unsigned char* KfT = lds + TILE_B; LAS unsigned char* KbT = lds + 2 * TILE_B;
    stage_T_b(VTt, proj + (size_t)row0 * PC + C_RV + 128 * h, tid);
    stage_rot_T2_b(KfT, KbT, proj + (size_t)row0 * PC + C_RK + 128 * h, rtc, rts, pos0, 0.088388347648318440f, lgf, lgb, tid);
    __syncthreads();
    const int wave = tid >> 6, lane = tid & 63, l15 = lane & 15, quad = lane >> 4;
    f32x4 af[8], ab[8]; zero8(af); zero8(ab);
    mma16(af, KfT, 16 * wave, VTt, lane); mma16(ab, KbT, 16 * wave, VTt, lane);
    bf16_t* of = KV + (size_t)(u * 2 + 0) * 16384; bf16_t* ob = KV + (size_t)(u * 2 + 1) * 16384;
#pragma unroll
    for (int cg = 0; cg < 8; ++cg) { const int e = 16 * cg + l15, d = 16 * wave + 4 * quad;
        u32x2 wf, wb2; wf.x = cvt_pk_bf16(af[cg][0], af[cg][1]); wf.y = cvt_pk_bf16(af[cg][2], af[cg][3]); wb2.x = cvt_pk_bf16(ab[cg][0], ab[cg][1]); wb2.y = cvt_pk_bf16(ab[cg][2], ab[cg][3]);
        *(u32x2*)(of + e * 128 + d) = wf; *(u32x2*)(ob + e * 128 + d) = wb2; }
    __syncthreads();
}
DI void scan(const Inputs& in, int l, unsigned char* ws, int half, int gtid, int NT) {
    const int L = half ? 2048 : 4096, NC = L / 128, NB = half ? 8 : 4;
    const bf16_t* KV = (const bf16_t*)(ws + WS_KV); bf16_t* SS = (bf16_t*)(ws + WS_KV + 32 * MiB);
    for (int idx = gtid; idx < NB * 32768; idx += NT) {
        const int elem = (idx & 4095) * 4, dir = (idx >> 12) & 1, h = (idx >> 13) & 3, s = idx >> 15;
        const float decay = __expf(128.f * logsig(in.ret_decay[l * 8 + dir * 4 + h]));
        const size_t base = ((size_t)(s * NC * 4 + h) * 2 + dir) * 16384 + elem;
        u32x2 v[32];
#pragma unroll
        for (int st = 0; st < 32; ++st) { const int n = dir ? NC - 1 - st : st; v[st] = st < NC ? *(const u32x2*)(KV + base + (size_t)n * 8 * 16384) : (u32x2){0u, 0u}; }
        float S0 = 0.f, S1 = 0.f, S2 = 0.f, S3 = 0.f;
#pragma unroll
        for (int st = 0; st < 32; ++st) { const int n = dir ? NC - 1 - st : st;
            if (st < NC) { u32x2 o; o.x = cvt_pk_bf16(S0, S1); o.y = cvt_pk_bf16(S2, S3); *(u32x2*)(SS + base + (size_t)n * 8 * 16384) = o;
                S0 = S0 * decay + bflo(v[st].x); S1 = S1 * decay + bfhi(v[st].x); S2 = S2 * decay + bflo(v[st].y); S3 = S3 * decay + bfhi(v[st].y); } }
    }
}
DI void out_unit(const Inputs& in, int l, unsigned char* ws, int half, int u, LAS unsigned char* lds, int tid) {
    asm volatile("" : "+v"(tid));
    const int L = half ? 2048 : 4096, NC = L / 128, h = u & 3, sn = u >> 2, s = sn / NC, n = sn % NC, row0 = s * L + n * 128, pos0 = n * 128;
    bf16_t* proj = (bf16_t*)(ws + WS_PROJ); const float* rtc = (const float*)(ws + WS_RTC); const float* rts = (const float*)(ws + WS_RTS);
    const bf16_t* SS = (const bf16_t*)(ws + WS_KV + 32 * MiB);
    const float lgf = logsig(in.ret_decay[l * 8 + h]), lgb = logsig(in.ret_decay[l * 8 + 4 + h]);
    const int wave = tid >> 6, lane = tid & 63, l15 = lane & 15, quad = lane >> 4;
    LAS unsigned char* Qt = lds; LAS unsigned char* Kt = lds + TILE_B; LAS unsigned char* VTt = lds + 2 * TILE_B; LAS unsigned char* Ps = lds + 3 * TILE_B + wave * (16 * TS * 2);
    stage_rot_rm_b(Qt, proj + (size_t)row0 * PC + C_RQ + 128 * h, rtc, rts, pos0, 1.0f, tid);
    stage_rot_rm_b(Kt, proj + (size_t)row0 * PC + C_RK + 128 * h, rtc, rts, pos0, 0.088388347648318440f, tid);
    stage_T_b(VTt, proj + (size_t)row0 * PC + C_RV + 128 * h, tid);
    __syncthreads();
    f32x4 O[8], F[8];
    zero8(F); mma16(F, Qt, 16 * wave, Kt, lane);
#pragma unroll
    for (int cg = 0; cg < 8; ++cg)
#pragma unroll
        for (int r = 0; r < 4; ++r) { const int i = 16 * wave + 4 * quad + r, j = 16 * cg + l15, df = i - j;
            const float fac = df >= 0 ? __expf((float)df * lgf) : __expf((float)(-df) * lgb);
            ((LAS bf16_t*)Ps)[sw(4 * quad + r, j)] = f2bf(F[cg][r] * fac); }
    LDS_WAIT();
    zero8(O); mma16(O, Ps, 0, VTt, lane);
    __syncthreads();
    stage_state(Kt, SS + (size_t)(u * 2 + 0) * 16384, tid); stage_state(VTt, SS + (size_t)(u * 2 + 1) * 16384, tid);
    __syncthreads();
    zero8(F); mma16(F, Qt, 16 * wave, Kt, lane);
#pragma unroll
    for (int r = 0; r < 4; ++r) { const int i = 16 * wave + 4 * quad + r; const float qwf = __expf((float)(i + 1) * lgf);
#pragma unroll
        for (int cg = 0; cg < 8; ++cg) O[cg][r] += qwf * F[cg][r]; }
    zero8(F); mma16(F, Qt, 16 * wave, VTt, lane);
    LAS bf16_t* Pn = (LAS bf16_t*)Ps;
#pragma unroll
    for (int r = 0; r < 4; ++r) { const int i = 16 * wave + 4 * quad + r; const float qwb = __expf((float)(128 - i) * lgb);
        float sm = 0.f;
#pragma unroll
        for (int cg = 0; cg < 8; ++cg) { O[cg][r] += qwb * F[cg][r]; sm += O[cg][r]; }
        sm += __shfl_xor(sm, 1); sm += __shfl_xor(sm, 2); sm += __shfl_xor(sm, 4); sm += __shfl_xor(sm, 8);
        const float mean = sm * (1.f / 128.f); float vs = 0.f;
#pragma unroll
        for (int cg = 0; cg < 8; ++cg) { const float dd = O[cg][r] - mean; vs += dd * dd; }
        vs += __shfl_xor(vs, 1); vs += __shfl_xor(vs, 2); vs += __shfl_xor(vs, 4); vs += __shfl_xor(vs, 8);
        const float rinv = __builtin_amdgcn_rsqf(vs * (1.f / 128.f) + EPS);
#pragma unroll
        for (int cg = 0; cg < 8; ++cg) Pn[(4 * quad + r) * TS + 16 * cg + l15] = f2bf((O[cg][r] - mean) * rinv);
    }
    LDS_WAIT();
    { const int rr = lane >> 2, part = lane & 3; bf16_t* rowp = proj + (size_t)(row0 + 16 * wave + rr) * PC + 128 * h + 32 * part;
      u32x4 gv[4];
#pragma unroll
      for (int q = 0; q < 4; ++q) gv[q] = *(const u32x4*)(rowp + C_RG + 8 * q);
#pragma unroll
      for (int q = 0; q < 4; ++q) { float g[8], o[8]; unpack8(gv[q], g); unpack8(*(const LAS u32x4*)(Pn + rr * TS + 32 * part + 8 * q), o);
#pragma unroll
          for (int e = 0; e < 8; ++e) o[e] = g[e] * sigmoidf_(g[e]) * o[e];
          u32x4 w; w.x = cvt_pk_bf16(o[0], o[1]); w.y = cvt_pk_bf16(o[2], o[3]); w.z = cvt_pk_bf16(o[4], o[5]); w.w = cvt_pk_bf16(o[6], o[7]);
          *(u32x4*)(rowp + C_RQ + 8 * q) = w; } }
    __syncthreads();
}
}


#define XB_TMO      128
#define XB_XCNT(j)  (256  + 64 * (j))
#define XB_XSUB(j)  (1280 + 64 * (j))
#define XB_XGEN(j)  (2304 + 64 * (j))
#define XB_TOP      3328
#define XB_TOPGEN   3392
#define XCD_BAR_WORDS 3456
#define XB_SPIN_CAP (1u << 22)
DI unsigned xb_ld(unsigned* p)              { return __hip_atomic_load(p, __ATOMIC_RELAXED, __HIP_MEMORY_SCOPE_AGENT); }
DI unsigned xb_add(unsigned* p, unsigned v) { return __hip_atomic_fetch_add(p, v, __ATOMIC_RELAXED, __HIP_MEMORY_SCOPE_AGENT); }
DI unsigned xb_xcc_id() { return (unsigned)__builtin_amdgcn_s_getreg((3 << 11) | 20) & 0xFu; }
#define XB_SPIN(cond, bar) do { unsigned _sp = 0; while (cond) { __builtin_amdgcn_s_sleep(1); \
    if ((++_sp & 255u) == 0u) { if (xb_ld(&(bar)[XB_TMO])) break; if (_sp > XB_SPIN_CAP) { atomicAdd(&(bar)[XB_TMO], 1u); break; } } } } while (0)
DI void xcd_barrier_complete(unsigned* bar, unsigned x, unsigned G, unsigned& nloc, unsigned& nx) {
    unsigned sum, cnt, mine, sp = 0u;
    for (;;) {
        sum = 0u; cnt = 0u; mine = 0u;
#pragma unroll
        for (unsigned j = 0; j < 16; ++j) { const unsigned c = xb_ld(&bar[XB_XCNT(j)]); sum += c; cnt += (c > 0u) ? 1u : 0u; mine = (j == x) ? c : mine; }
        if (sum == G) break;
        __builtin_amdgcn_s_sleep(1);
        if ((++sp & 255u) == 0u) { if (xb_ld(&bar[XB_TMO])) break; if (sp > XB_SPIN_CAP) { atomicAdd(&bar[XB_TMO], 1u); break; } }
    }
    nloc = mine > 0u ? mine : 1u; nx = cnt > 0u ? cnt : 1u;
}
DI void xcd_barrier(unsigned* bar, volatile LAS unsigned* st, bool leader, unsigned G) {
    asm volatile("s_waitcnt vmcnt(0)" ::: "memory");
    __syncthreads();
    if (leader) {
        const unsigned x = xb_xcc_id();
        __builtin_amdgcn_s_waitcnt(0);
        unsigned nloc = st[0], nx = st[1];
        if (nloc == 0u) { xcd_barrier_complete(bar, x, G, nloc, nx); st[0] = nloc; st[1] = nx; }
        const unsigned old = xb_add(&bar[XB_XSUB(x)], 1u);
        const unsigned gen = old / nloc;
        if (old + 1u == (gen + 1u) * nloc) {
            __builtin_amdgcn_fence(__ATOMIC_RELEASE, "agent");
            asm volatile("s_waitcnt vmcnt(0)" ::: "memory");
            const unsigned og = xb_add(&bar[XB_TOP], 1u);
            const unsigned tg = og / nx;
            if (og + 1u == (tg + 1u) * nx) xb_add(&bar[XB_TOPGEN], 1u);
            else XB_SPIN(xb_ld(&bar[XB_TOPGEN]) == tg, bar);
            __builtin_amdgcn_fence(__ATOMIC_ACQUIRE, "agent");
            xb_add(&bar[XB_XGEN(x)], 1u);
            asm volatile("s_waitcnt vmcnt(0)" ::: "memory");
        } else {
            XB_SPIN(xb_ld(&bar[XB_XGEN(x)]) == gen, bar);
            __builtin_amdgcn_fence(__ATOMIC_ACQUIRE, "agent");
            asm volatile("s_waitcnt vmcnt(0)" ::: "memory");
        }
    }
    __syncthreads();
}

struct SchedGrid { const char* A; const char* B; int nM, nN, G, c; size_t astep, bstep;
    DI bool next(int i, Unit& u) const { const int L = i * G + c; if (L >= nM * nN) return false; int pm, pn; pg8::tile_order(nM, nN, L, pm, pn);
        u.A = A + (size_t)pm * astep; u.B = B + (size_t)pn * bstep; u.pm = pm; u.pn = pn; u.z = 0; return true; } };
struct SchedA1 { const char* XN; const char* Win; const char* MN; const char* Wkv; int G, c, extra;
    DI bool next(int i, Unit& u) const { int L = i * G + c;
        if (L < 1920) { int pm, pn; pg8::tile_order(64, 30, L, pm, pn); u.A = XN + (size_t)pm * 256 * 1024 * 2; u.B = Win + (size_t)pn * 256 * 1024 * 2; u.pm = pm; u.pn = pn; u.z = 0; return true; }
        if (!extra) return false;
        L -= 1920;
        if (L < 48) { const int pm = L >> 2, pn = L & 3; u.A = MN + (size_t)pm * 256 * 1024 * 2; u.B = Wkv + (size_t)pn * 256 * 1024 * 2; u.pm = pm; u.pn = pn; u.z = 1; return true; }
        L -= 48;
        if (L < 48) { const int bm = L >> 2, pm = L & 3; u.A = Wkv + (size_t)(1024 + pm * 256) * 1024 * 2; u.B = MN + (size_t)bm * 256 * 1024 * 2; u.pm = pm; u.pn = 0; u.z = 2 + bm; return true; }
        return false; } };
struct FA1 { bf16_t *O, *KK, *VVT;
    DI void operator()(const Unit& u, int r, int c, f32x4 a, f32x4 b) const {
        if (u.z == 0) { const int col = u.pn * 256 + c;
            if (col >= C_G) {
                unsigned q[8];
#pragma unroll
                for (int e = 0; e < 4; ++e) { q[e] = (unsigned)(sigmoidf_(a[e]) * 255.f + 0.5f); q[4 + e] = (unsigned)(sigmoidf_(b[e]) * 255.f + 0.5f); }
                u32x2 w; w.x = q[0] | (q[1] << 8) | (q[2] << 16) | (q[3] << 24); w.y = q[4] | (q[5] << 8) | (q[6] << 16) | (q[7] << 24);
                *(u32x2*)((unsigned char*)(O + (size_t)(u.pm * 256 + r) * PC + C_G) + (col - C_G)) = w; }
            else *(u32x4*)(O + (size_t)(u.pm * 256 + r) * PC + col) = pack8(a, b); }
        else if (u.z == 1) *(u32x4*)(KK + (size_t)(u.pm * 256 + r) * 1024 + u.pn * 256 + c) = pack8(a, b);
        else *(u32x4*)(VVT + ((size_t)(u.z - 2) * 1024 + u.pm * 256 + r) * 256 + c) = pack8(a, b); } };
struct SchedBranch { const char* proj; const char* W; int G, c;
    DI bool next(int i, Unit& u) const { const int mac = (i / 3) * G + c, br = i % 3; if (mac >= 256) return false; int pm, pn; pg8::tile_order(64, 4, mac, pm, pn);
        const int acol = br == 0 ? C_YH : (br == 1 ? C_RQ : C_AQ);
        u.A = proj + ((size_t)pm * 256 * PC + acol) * 2; u.B = W + ((size_t)br * 1024 * 512 + (size_t)pn * 256 * 512) * 2; u.pm = pm; u.pn = pn; u.z = br; return true; } };
struct SchedX1 { const char* XN; const char* MN; const char* Wq; const char* Wkv; int G, c;
    DI bool next(int i, Unit& u) const { int L = i * G + c;
        if (L < 512) { int pm, pn; pg8::tile_order(128, 4, L, pm, pn); u.A = XN + (size_t)pm * 256 * 1024 * 2; u.B = Wq + (size_t)pn * 256 * 1024 * 2; u.pm = pm; u.pn = pn; u.z = 0; return true; }
        L -= 512;
        if (L < 48) { const int pm = L >> 2, pn = L & 3; u.A = MN + (size_t)pm * 256 * 1024 * 2; u.B = Wkv + (size_t)pn * 256 * 1024 * 2; u.pm = pm; u.pn = pn; u.z = 1; return true; }
        L -= 48;
        if (L < 48) { const int bm = L >> 2, pm = L & 3; u.A = Wkv + (size_t)(1024 + pm * 256) * 1024 * 2; u.B = MN + (size_t)bm * 256 * 1024 * 2; u.pm = pm; u.pn = 0; u.z = 2 + bm; return true; }
        return false; } };
DI int mem_batch(int row0) { return row0 < 16384 ? (row0 >> 12) : 4 + ((row0 - 16384) >> 11); }
struct SchedX2 { const char* QX; const char* KK; int G, c;
    DI bool next(int i, Unit& u) const { const int L = i * G + c; if (L >= 512) return false; const int pm = L >> 2, h = L & 3, bm = mem_batch(pm * 256);
        u.A = QX + ((size_t)pm * 256 * 1024 + 256 * h) * 2; u.B = KK + ((size_t)bm * 256 * 1024 + 256 * h) * 2; u.pm = pm; u.pn = h; u.z = h; return true; } };
struct SchedX3 { const char* P; const char* VVT; int G, c;
    DI bool next(int i, Unit& u) const { const int L = i * G + c; if (L >= 512) return false; const int pm = L >> 2, h = L & 3, bm = mem_batch(pm * 256);
        u.A = P + ((size_t)pm * 256 * 1024 + 256 * h) * 2; u.B = VVT + ((size_t)(bm * 1024 + 256 * h) * 256) * 2; u.pm = pm; u.pn = h; u.z = h; return true; } };

struct FProj { bf16_t* O;
    DI void operator()(const Unit& u, int r, int c, f32x4 a, f32x4 b) const { const int col = u.pn * 256 + c;
        if (col >= C_G) {
#pragma unroll
            for (int e = 0; e < 4; ++e) { a[e] = sigmoidf_(a[e]); b[e] = sigmoidf_(b[e]); } }
        *(u32x4*)(O + (size_t)(u.pm * 256 + r) * PC + col) = pack8(a, b); } };
template <int ACT> struct FStore { bf16_t* O; int ldc; float sc;
    DI void operator()(const Unit& u, int r, int c, f32x4 a, f32x4 b) const {
        if (ACT == 1) {
#pragma unroll
            for (int e = 0; e < 4; ++e) { const float x = fmaxf(a[e], 0.f), y = fmaxf(b[e], 0.f); a[e] = x * x; b[e] = y * y; } }
        *(u32x4*)(O + (size_t)(u.pm * 256 + r) * ldc + u.pn * 256 + c) = pack8(a * sc, b * sc); } };
struct EpiBranch { const bf16_t* proj; bf16_t* M;
    DI void operator()(f32x4 (&acc)[2][2][4][2], const Unit& u, int wr, int wc, int fr, int fq, LAS unsigned char*) const {
        asm volatile("" : "+v"(fr), "+v"(fq));
#pragma unroll
        for (int ai = 0; ai < 2; ++ai) {
            u32x2 gv[4][2]; u32x4 pv[4][2];
#pragma unroll
            for (int m = 0; m < 4; ++m)
#pragma unroll
                for (int bj = 0; bj < 2; ++bj) { const int row = u.pm * 256 + ai * 128 + wr * 64 + m * 16 + fr, col = u.pn * 256 + bj * 128 + wc * 32 + 8 * fq;
                    gv[m][bj] = *(const u32x2*)((const unsigned char*)(proj + (size_t)row * PC + C_G) + u.z * 1024 + col);
                    pv[m][bj] = (u32x4){0u, 0u, 0u, 0u}; if (u.z) pv[m][bj] = *(const u32x4*)(M + (size_t)row * 1024 + col); }
#pragma unroll
            for (int m = 0; m < 4; ++m)
#pragma unroll
                for (int bj = 0; bj < 2; ++bj) { const int row = u.pm * 256 + ai * 128 + wr * 64 + m * 16 + fr, col = u.pn * 256 + bj * 128 + wc * 32 + 8 * fq;
                    float g[8], p[8]; unpack8g(pv[m][bj], p);
#pragma unroll
                    for (int e = 0; e < 4; ++e) { g[e] = (float)((gv[m][bj].x >> (8 * e)) & 0xffu) * (1.f / 255.f); g[4 + e] = (float)((gv[m][bj].y >> (8 * e)) & 0xffu) * (1.f / 255.f); }
                    f32x4 a = acc[ai][bj][m][0], b = acc[ai][bj][m][1];
#pragma unroll
                    for (int e = 0; e < 4; ++e) { a[e] = a[e] * g[e] + p[e]; b[e] = b[e] * g[4 + e] + p[4 + e]; }
                    *(u32x4*)(M + (size_t)row * 1024 + col) = pack8(a, b); }
        }
    } };
struct FX1 { bf16_t *QX, *KK, *VVT;
    DI void operator()(const Unit& u, int r, int c, f32x4 a, f32x4 b) const {
        if (u.z == 0) *(u32x4*)(QX + (size_t)(u.pm * 256 + r) * 1024 + u.pn * 256 + c) = pack8(a * 0.0625f, b * 0.0625f);
        else if (u.z == 1) *(u32x4*)(KK + (size_t)(u.pm * 256 + r) * 1024 + u.pn * 256 + c) = pack8(a, b);
        else *(u32x4*)(VVT + ((size_t)(u.z - 2) * 1024 + u.pm * 256 + r) * 256 + c) = pack8(a, b); } };

__global__ void __launch_bounds__(512, 2) mega(Args args) {
    extern __shared__ __attribute__((aligned(16))) unsigned char lds_g[];
    cg::grid_group grid = cg::this_grid();
    LAS unsigned char* lds = (LAS unsigned char*)lds_g;
    LAS unsigned char* lx = lds + LDS_X;
    const int G0 = gridDim.x, bx0 = blockIdx.x, wave0 = __builtin_amdgcn_readfirstlane(threadIdx.x >> 6);
    const int vcu0 = (G0 % 8 == 0) ? (bx0 % 8) * (G0 / 8) + bx0 / 8 : bx0;
    const int lo = args.ph_lo, hi = args.ph_hi; int ph = 0;
    { const int t0 = opaque_tid(wave0);
      if (t0 < 2) ((volatile LAS unsigned*)(lds + LDS_ST))[t0] = 0u;
      __syncthreads();
      if (t0 == 0) (void)xb_add(&((unsigned*)args.ws)[XB_XCNT(xb_xcc_id())], 1u); }
    typedef const __attribute__((address_space(4))) Args* KArgsP;
#if defined(__HIP_DEVICE_COMPILE__)
#define LOAD_ARGS(p) (*(p))
#else
#define LOAD_ARGS(p) (args)
#endif
#define PH_BEGIN if (ph >= lo && ph < hi) { KArgsP kp_ = (KArgsP)__builtin_amdgcn_kernarg_segment_ptr(); asm volatile("" : "+s"(kp_)); const Args A_ = LOAD_ARGS(kp_); \
        const Inputs& in = A_.in; unsigned char* ws = A_.ws; float* xo = A_.out; (void)in; (void)xo; \
        int G = G0, bx = bx0, vcu = vcu0, wave = wave0; asm volatile("" : "+s"(G), "+s"(bx), "+s"(vcu), "+s"(wave)); \
        const int tid = opaque_tid(wave), lane = tid & 63, gtid = bx * 512 + tid, gw = vcu * 8 + wave, NGW = G * 8, NT = G * 512; (void)lane; (void)gtid; (void)gw; (void)NGW; (void)NT; \
        const char* wb = (const char*)(ws + WS_WB); bf16_t* XN = (bf16_t*)xo; bf16_t* XB = (bf16_t*)(ws + WS_XN); (void)XB; \
        bf16_t* MNb = XN + (size_t)TT * D; bf16_t* KKb = MNb + (size_t)3072 * D; bf16_t* VVTb = KKb + (size_t)3072 * D; (void)MNb; (void)KKb; (void)VVTb;     bf16_t* R = (bf16_t*)(ws + WS_R); bf16_t* proj = (bf16_t*)(ws + WS_PROJ); (void)wb; (void)XN; (void)R; (void)proj;
#define PH_END } ++ph; if (ph > lo && ph < hi) { if (ph == 1) grid.sync(); else { KArgsP kq_ = (KArgsP)__builtin_amdgcn_kernarg_segment_ptr(); asm volatile("" : "+s"(kq_)); \
        xcd_barrier((unsigned*)LOAD_ARGS(kq_).ws, (volatile LAS unsigned*)(lds + LDS_ST), opaque_tid(wave0) == 0, (unsigned)G0); } }

    PH_BEGIN
        make_tables(ws, gtid, NT);
        convert_weights(in, 0, ws, lds, gw, NGW, wave, lane);
        filter_gen(in, 0, ws, lds, vcu, G, wave, tid);
        for (int m0 = gw; m0 < TT; m0 += 4 * NGW) {
            f32x4 v[4][4];
#pragma unroll
            for (int q = 0; q < 4; ++q) { const int m = m0 + q * NGW; const float* xi = m < HT ? in.x_prompt + (size_t)m * D : in.x_sample + (size_t)(m - HT) * D;
#pragma unroll
                for (int j = 0; j < 4; ++j) v[q][j] = __builtin_nontemporal_load((const f32x4*)(xi + 4 * lane + 256 * j)); }
            float ss[4];
#pragma unroll
            for (int q = 0; q < 4; ++q) { ss[q] = 0.f; const size_t m = (size_t)m0 + q * NGW;
#pragma unroll
                for (int j = 0; j < 4; ++j) { u32x2 w; w.x = cvt_pk_bf16(v[q][j][0], v[q][j][1]); w.y = cvt_pk_bf16(v[q][j][2], v[q][j][3]); *(u32x2*)(XB + m * D + 4 * lane + 256 * j) = w;
                    v[q][j] = (f32x4){bflo(w.x), bfhi(w.x), bflo(w.y), bfhi(w.y)};
                    ss[q] += (v[q][j][0] * v[q][j][0] + v[q][j][1] * v[q][j][1]) + (v[q][j][2] * v[q][j][2] + v[q][j][3] * v[q][j][3]); } }
#pragma unroll
            for (int o = 1; o < 64; o <<= 1)
#pragma unroll
                for (int q = 0; q < 4; ++q) ss[q] += __shfl_xor(ss[q], o);
#pragma unroll
            for (int q = 0; q < 4; ++q) { const float rinv = __builtin_amdgcn_rsqf(ss[q] * (1.f / 1024.f) + EPS); const size_t m = (size_t)m0 + q * NGW;
#pragma unroll
                for (int j = 0; j < 4; ++j) { const f32x4 g = *(const f32x4*)(in.g_mix_pre + 4 * lane + 256 * j); const f32x4 o = v[q][j] * rinv * g;
                    u32x2 w; w.x = cvt_pk_bf16(o[0], o[1]); w.y = cvt_pk_bf16(o[2], o[3]); *(u32x2*)(XN + m * D + 4 * lane + 256 * j) = w; } }
        }
    PH_END

    for (int l = 0; l < DEPTH; ++l) {
        for (int half = 0; half < 2; ++half) {
            const int L = half ? 2048 : 4096;
            PH_BEGIN
                SchedA1 S{(const char*)(XN + (size_t)half * HT * D), wb + WB_IN, (const char*)MNb, wb + WB_XKV, G, bx, half};
                pg8::EpiRows<FA1> E{FA1{proj, KKb, VVTb}};
                pg8::gemm_phase(wave, lds, lx, GemmP{1024, 1024, 1024}, S, E);
            PH_END
            PH_BEGIN
                prep_attn(in, l, ws, half, gw, NGW, lane);
                prep_hyena(in, l, ws, half, vcu, G, tid);
                for (int u = vcu; u < 512; u += G) ret::kv_unit(in, l, ws, half, u, lds, tid);
            PH_END
            PH_BEGIN
                ret::scan(in, l, ws, half, gtid, NT);
                const int nqb = L / 256;
                for (int u = vcu; u < 256; u += G) { const int qb = u % nqb, sh = u / nqb, g2 = sh & 1, kvh = (sh >> 1) & 1, s = sh >> 2, h = 2 * kvh + g2;
                    bf16_t* Qb = proj + (size_t)(s * L + qb * 256) * PC + C_AQ + 128 * h;
                    const bf16_t* Kh = proj + (size_t)(s * L) * PC + C_AK + 128 * kvh; const bf16_t* Vh = proj + (size_t)(s * L) * PC + C_AV + 128 * kvh;
                    attn::attn_dense_body(wave, Qb, Kh, Vh, Qb, L, (char*)lds_g); }
                for (int c = vcu; c < 512; c += G) hyena_unit(in, l, ws, half, c, lds, tid);
            PH_END
            PH_BEGIN
                for (int u = vcu; u < 512; u += G) ret::out_unit(in, l, ws, half, u, lds, tid);
                post_hyena(ws, half, lds, vcu, G, tid);
            PH_END
            PH_BEGIN
                SchedBranch S{(const char*)proj, wb + WB_BR, G, bx};
                EpiBranch E{proj, XN + (size_t)half * HT * D};
                pg8::gemm_phase(wave, lds, lx, GemmP{PC, 512, 512}, S, E);
            PH_END
            PH_BEGIN
                SchedGrid S{(const char*)(XN + (size_t)half * HT * D), wb + WB_OUT, 64, 4, G, bx, (size_t)256 * 1024 * 2, (size_t)256 * 1024 * 2};
                pg8::EpiRows<FStore<0>> E{FStore<0>{R + (size_t)half * HT * D, 1024, 1.f}};
                pg8::gemm_phase(wave, lds, lx, GemmP{1024, 1024, 1024}, S, E);
            PH_END
            PH_BEGIN
                for (int m = gw; m < HT; m += 4 * NGW) norm_rows<true, 4>(XB, R, in.g_mix_post + l * D, XB, in.g_x_pre + l * D, XN, (size_t)half * HT + m, (size_t)NGW, lane);
                if (half == 0) for (int m = gw; m < 3072; m += NGW) { const float* mi = m < 1024 ? in.mem_prompt + (size_t)m * D : in.mem_sample + (size_t)(m - 1024) * D;
                    norm_row<false, true>(mi, nullptr, nullptr, nullptr, in.g_mem + l * D, MNb + (size_t)m * D, lane); }
            PH_END
        }
        PH_BEGIN
            SchedGrid S{(const char*)XN, wb + WB_XQ, 128, 4, G, bx, (size_t)256 * 1024 * 2, (size_t)256 * 1024 * 2};
            pg8::EpiRows<FStore<0>> E{FStore<0>{(bf16_t*)(ws + WS_QX), 1024, 0.0625f}};
            pg8::gemm_phase(wave, lds, lx, GemmP{1024, 1024, 1024}, S, E);
        PH_END
        PH_BEGIN
            SchedX2 S{(const char*)(ws + WS_QX), (const char*)KKb, G, bx};
            pg8::EpiSoftmax E{(bf16_t*)(ws + WS_P), 1024};
            pg8::gemm_phase(wave, lds, lx, GemmP{1024, 1024, 256}, S, E);
        PH_END
        PH_BEGIN
            SchedX3 S{(const char*)(ws + WS_P), (const char*)VVTb, G, bx};
            pg8::EpiRows<FStore<0>> E{FStore<0>{(bf16_t*)(ws + WS_OX), 1024, 1.f}};
            pg8::gemm_phase(wave, lds, lx, GemmP{1024, 256, 256}, S, E);
        PH_END
        PH_BEGIN
            SchedGrid S{(const char*)(ws + WS_OX), wb + WB_XO, 128, 4, G, bx, (size_t)256 * 1024 * 2, (size_t)256 * 1024 * 2};
            pg8::EpiRows<FStore<0>> E{FStore<0>{R, 1024, 1.f}};
            pg8::gemm_phase(wave, lds, lx, GemmP{1024, 1024, 1024}, S, E);
        PH_END
        PH_BEGIN
            for (int m = gw; m < TT; m += 4 * NGW) norm_rows<true, 4>(XB, R, in.g_x_post + l * D, XB, in.g_ff_pre + l * D, XN, (size_t)m, (size_t)NGW, lane);
        PH_END
        PH_BEGIN
            SchedGrid S{(const char*)XN, wb + WB_F1, 128, 16, G, bx, (size_t)256 * 1024 * 2, (size_t)256 * 1024 * 2};
            pg8::EpiRows<FStore<1>> E{FStore<1>{(bf16_t*)(ws + WS_U), 4096, 1.f}};
            pg8::gemm_phase(wave, lds, lx, GemmP{1024, 1024, 1024}, S, E);
        PH_END
        PH_BEGIN
            SchedGrid S{(const char*)(ws + WS_U), wb + WB_F2, 128, 4, G, bx, (size_t)256 * 4096 * 2, (size_t)256 * 4096 * 2};
            pg8::EpiRows<FStore<0>> E{FStore<0>{R, 1024, 1.f}};
            pg8::gemm_phase(wave, lds, lx, GemmP{4096, 4096, 4096}, S, E);
        PH_END
        PH_BEGIN
            const bool more = l + 1 < DEPTH;
            if (more) { for (int m = gw; m < TT; m += 4 * NGW) norm_rows<true, 4>(XB, R, in.g_ff_post + l * D, XB, in.g_mix_pre + (l + 1) * D, XN, (size_t)m, (size_t)NGW, lane); }
            else { for (int m = gw; m < TT; m += 4 * NGW) norm_rows<false, 4>(XB, R, in.g_ff_post + l * D, xo, nullptr, nullptr, (size_t)m, (size_t)NGW, lane); }
            if (more) { convert_weights(in, l + 1, ws, lds, gw, NGW, wave, lane); filter_gen(in, l + 1, ws, lds, vcu, G, wave, tid); }
        PH_END
    }
#undef PH_BEGIN
#undef PH_END
}

extern "C" void kernel_launch(void* const* d_in, const int* in_sizes, int n_in, void* d_out, int out_size, void* d_ws, size_t ws_size, hipStream_t stream) {
    static int grid = 0;
    if (grid == 0) {
        if (n_in != 29 || out_size != TT * D || ws_size < WS_END) { fprintf(stderr, "kernel_launch: unexpected shapes: n_in %d out %d ws %zu (need %zu)\n", n_in, out_size, ws_size, (size_t)WS_END); grid = -1; return; }
        int dev = 0, cus = 0, per_cu = 0;
        hipGetDevice(&dev); hipDeviceGetAttribute(&cus, hipDeviceAttributeMultiprocessorCount, dev);
        if (hipFuncSetAttribute((const void*)mega, hipFuncAttributeMaxDynamicSharedMemorySize, LDS_BYTES) != hipSuccess) { fprintf(stderr, "kernel_launch: hipFuncSetAttribute failed\n"); grid = -1; return; }
        if (hipOccupancyMaxActiveBlocksPerMultiprocessor(&per_cu, (const void*)mega, 512, LDS_BYTES) != hipSuccess || per_cu < 1) { fprintf(stderr, "kernel_launch: occupancy query gave %d\n", per_cu); per_cu = 1; }
        (void)hipGetLastError();
        grid = cus * 1;
    }
    if (grid < 0) return;
    Args a{};
    const float** ip = (const float**)&a.in;
    for (int i = 0; i < 29; ++i) ip[i] = (const float*)d_in[i];
    a.out = (float*)d_out; a.ws = (unsigned char*)d_ws; a.ph_lo = 0; a.ph_hi = 1 << 30;
    (void)hipMemsetAsync(d_ws, 0, 16384, stream);
    void* params[] = {&a};
    const hipError_t e = hipLaunchCooperativeKernel((const void*)mega, dim3(grid), dim3(512), params, LDS_BYTES, stream);
    if (e != hipSuccess) fprintf(stderr, "kernel_launch: cooperative launch failed: %s (grid %d)\n", hipGetErrorString(e), grid);
}
```

```cpp
#include <hip/hip_runtime.h>
#include <hip/hip_cooperative_groups.h>
#include <cstdio>
#include <cstdint>
namespace cg = cooperative_groups;

#define LAS __attribute__((address_space(3)))
#define DI __device__ __forceinline__
typedef unsigned short bf16_t;
typedef short bf16x8 __attribute__((ext_vector_type(8)));
typedef short s16x4 __attribute__((ext_vector_type(4)));
typedef float f32x4 __attribute__((ext_vector_type(4)));
typedef float f32x2 __attribute__((ext_vector_type(2)));
typedef float f32x8 __attribute__((ext_vector_type(8)));
typedef float f32x16 __attribute__((ext_vector_type(16)));
typedef unsigned u32x4 __attribute__((ext_vector_type(4)));
typedef unsigned u32x2 __attribute__((ext_vector_type(2)));

constexpr int D = 1024, TT = 32768, HT = 16384, DEPTH = 4, DFF = 4096;
constexpr int PC = 8192;
constexpr int C_X0 = 0, C_X1 = 512, C_V = 1024, C_RQ = 1536, C_RK = 2048, C_RV = 2560, C_RG = 3072, C_AQ = 3584, C_AK = 4096, C_AV = 4352, C_G = 4608, C_YH = 7680;
constexpr int INC = 7680;
constexpr float EPS = 1e-6f;

constexpr size_t MiB = 1u << 20;
constexpr size_t WS_RTC = 1 * MiB, WS_RTS = 2 * MiB, WS_AXC = 3 * MiB, WS_AXS = 3 * MiB + 65536;
constexpr int FRS0 = 8192 + 64, FRS1 = 4096 + 64;
constexpr size_t WS_FR0 = 4 * MiB, WS_FR1 = WS_FR0 + (size_t)512 * FRS0 * 2;
constexpr size_t WS_WB = 17 * MiB;
constexpr size_t WB_IN = 0, WB_BR = WB_IN + (size_t)INC * 1024 * 2, WB_OUT = WB_BR + (size_t)3 * 1024 * 512 * 2, WB_XQ = WB_OUT + (size_t)1024 * 1024 * 2,
                 WB_XKV = WB_XQ + (size_t)1024 * 1024 * 2, WB_XO = WB_XKV + (size_t)2048 * 1024 * 2, WB_F1 = WB_XO + (size_t)1024 * 1024 * 2, WB_F2 = WB_F1 + (size_t)4096 * 1024 * 2,
                 WB_END = WB_F2 + (size_t)4096 * 1024 * 2;
static_assert(WB_END == 44 * MiB, "wb");
constexpr size_t WS_XN = 61 * MiB, WS_R = 125 * MiB, WS_BIG = 189 * MiB;
constexpr size_t WS_PROJ = WS_BIG, WS_ZT = WS_BIG + 256 * MiB, WS_X0T = WS_ZT + 16 * MiB, WS_FRO0 = WS_X0T + 16 * MiB, WS_FRO1 = WS_FRO0 + (size_t)512 * FRS0 * 2, WS_END = WS_FRO1 + (size_t)512 * FRS1 * 2;
constexpr size_t WS_QX = WS_BIG, WS_P = WS_BIG + 64 * MiB, WS_OX = WS_BIG + 128 * MiB, WS_MN = WS_BIG + 192 * MiB, WS_KK = WS_MN + 6 * MiB, WS_VVT = WS_KK + 6 * MiB;
constexpr size_t WS_U = WS_BIG;
constexpr size_t WS_KV = WS_R;

constexpr int LDS_BYTES = 147456;
constexpr int LDS_X = 131072;
constexpr int LDS_ST = 147456 - 64;

typedef __bf16 bf16x2_t __attribute__((ext_vector_type(2)));
DI unsigned cvt_pk_bf16(float lo, float hi) { const f32x2 v = {lo, hi}; return __builtin_bit_cast(unsigned, __builtin_convertvector(v, bf16x2_t)); }
DI bf16_t f2bf(float f) { return __builtin_bit_cast(bf16_t, (__bf16)f); }
DI float bf2f(bf16_t v) { return __uint_as_float(((unsigned)v) << 16); }
DI float bflo(unsigned w) { return __uint_as_float(w << 16); }
DI float bfhi(unsigned w) { return __uint_as_float(w & 0xffff0000u); }
DI float wave_sum(float v) {
#pragma unroll
    for (int o = 1; o < 64; o <<= 1) v += __shfl_xor(v, o);
    return v;
}
DI float sigmoidf_(float x) { return __builtin_amdgcn_rcpf(1.f + __builtin_amdgcn_exp2f(-1.4426950408889634f * x)); }
#define LDS_WAIT() asm volatile("s_waitcnt lgkmcnt(0)" ::: "memory")
DI void unpack8g(const u32x4 w, float (&f)[8]) { f[0] = bflo(w.x); f[1] = bfhi(w.x); f[2] = bflo(w.y); f[3] = bfhi(w.y); f[4] = bflo(w.z); f[5] = bfhi(w.z); f[6] = bflo(w.w); f[7] = bfhi(w.w); }
DI int opaque_tid(int wave) { int t = wave * 64 + (int)__builtin_amdgcn_mbcnt_hi(~0u, __builtin_amdgcn_mbcnt_lo(~0u, 0u)); asm volatile("" : "+v"(t)); return t; }

namespace pg8 {
constexpr int BM = 256, BK = 64, HALF = 128, HTB = HALF * BK * 2, STAGE_BYTES = 8 * HTB, NXCD = 8, WGM = 8;
__host__ __device__ __forceinline__ int lds_byte(int r, int c) { const int st = (r >> 4) * 2 + (c >> 5), rr = r & 15, cc = c & 31, ob = rr * 64 + cc * 2; return st * 1024 + (ob ^ (((ob >> 9) & 1) << 5)); }
__host__ __device__ __forceinline__ void stage_rc(int b, int& R, int& C) { const int st = b / 1024, sb = b % 1024, swz = sb ^ (((sb >> 9) & 1) << 5); R = (st >> 1) * 16 + swz / 64; C = (st & 1) * 32 + (swz % 64) / 2; }
__host__ __device__ __forceinline__ int perm32(int rho) { const int n = rho >> 4, i = rho & 15; return 8 * (i >> 2) + 4 * n + (i & 3); }

struct Unit { const char* A; const char* B; int pm, pn, z; };
struct GemmP { int lda, ldb, K; };

DI void tile_order(int nM, int nN, int L, int& pm, int& pn) {
    const int nwg = nM * nN; int wgid = L;
    { const int q = nwg / NXCD, r = nwg % NXCD, xcd = wgid % NXCD, off = wgid / NXCD; wgid = (xcd < r ? xcd * (q + 1) : r * (q + 1) + (xcd - r) * q) + off; }
    const int nig = WGM * nN, gid = wgid / nig, fm = gid * WGM, gsz = (nM - fm) < WGM ? (nM - fm) : WGM;
    pm = fm + ((wgid % nig) % gsz); pn = (wgid % nig) / gsz;
}

template <class F> struct EpiRows {
    F f;
    DI void operator()(f32x4 (&acc)[2][2][4][2], const Unit& u, int wr, int wc, int fr, int fq, LAS unsigned char*) const {
        asm volatile("" : "+v"(fr), "+v"(fq));
#pragma unroll
        for (int ai = 0; ai < 2; ++ai)
#pragma unroll
            for (int m = 0; m < 4; ++m) { const int r = ai * HALF + wr * 64 + m * 16 + fr;
#pragma unroll
                for (int bj = 0; bj < 2; ++bj) { const int c = bj * HALF + wc * 32 + 8 * fq; f(u, r, c, acc[ai][bj][m][0], acc[ai][bj][m][1]); } }
    }
};
DI u32x4 pack8(f32x4 a, f32x4 b) { u32x4 w; w.x = cvt_pk_bf16(a[0], a[1]); w.y = cvt_pk_bf16(a[2], a[3]); w.z = cvt_pk_bf16(b[0], b[1]); w.w = cvt_pk_bf16(b[2], b[3]); return w; }

struct EpiSoftmax {
    bf16_t* O; int ldc;
    DI void operator()(f32x4 (&acc)[2][2][4][2], const Unit& u, int wr, int wc, int fr, int fq, LAS unsigned char* lx) const {
        asm volatile("" : "+v"(fr), "+v"(fq));
        LAS f32x2* X = (LAS f32x2*)lx;
#pragma unroll
        for (int ai = 0; ai < 2; ++ai)
#pragma unroll
            for (int m = 0; m < 4; ++m) {
                float mx = -3.0e38f;
#pragma unroll
                for (int bj = 0; bj < 2; ++bj)
#pragma unroll
                    for (int n = 0; n < 2; ++n) { const f32x4 x = acc[ai][bj][m][n]; mx = fmaxf(mx, fmaxf(fmaxf(x[0], x[1]), fmaxf(x[2], x[3]))); }
                mx = fmaxf(mx, __shfl_xor(mx, 16)); mx = fmaxf(mx, __shfl_xor(mx, 32));
                float s = 0.f;
#pragma unroll
                for (int bj = 0; bj < 2; ++bj)
#pragma unroll
                    for (int n = 0; n < 2; ++n) { f32x4 x = acc[ai][bj][m][n];
#pragma unroll
                        for (int e = 0; e < 4; ++e) { x[e] = __expf(x[e] - mx); s += x[e]; }
                        acc[ai][bj][m][n] = x; }
                s += __shfl_xor(s, 16); s += __shfl_xor(s, 32);
                if (fq == 0) X[(ai * HALF + wr * 64 + m * 16 + fr) * 4 + wc] = (f32x2){mx, s};
                __builtin_amdgcn_sched_barrier(0);
            }
        LDS_WAIT(); __builtin_amdgcn_s_barrier(); asm volatile("" ::: "memory");
#pragma unroll
        for (int ai = 0; ai < 2; ++ai)
#pragma unroll
            for (int m = 0; m < 4; ++m) {
                const int r = ai * HALF + wr * 64 + m * 16 + fr;
                const f32x2 a = X[r * 4 + 0], b = X[r * 4 + 1], c = X[r * 4 + 2], d = X[r * 4 + 3];
                const float M = fmaxf(fmaxf(a.x, b.x), fmaxf(c.x, d.x));
                const float S = a.y * __expf(a.x - M) + b.y * __expf(b.x - M) + c.y * __expf(c.x - M) + d.y * __expf(d.x - M);
                const float fac = __expf(X[r * 4 + wc].x - M) / S;
                bf16_t* rowp = O + (size_t)(u.pm * BM + r) * ldc + u.z * 256 + wc * 32 + 8 * fq;
#pragma unroll
                for (int bj = 0; bj < 2; ++bj) *(u32x4*)(rowp + bj * HALF) = pack8(acc[ai][bj][m][0] * fac, acc[ai][bj][m][1] * fac);
                __builtin_amdgcn_sched_barrier(0);
            }
        LDS_WAIT(); __builtin_amdgcn_s_barrier(); asm volatile("" ::: "memory");
    }
};

template <class Epi, class Sched>
DI void gemm_phase(int wave_, LAS unsigned char* lds, LAS unsigned char* lx, const GemmP g, const Sched& S, const Epi& E) {
    const int tid = opaque_tid(wave_), wid = __builtin_amdgcn_readfirstlane(tid >> 6), lane = tid & 63, wr = wid >> 2, wc = wid & 3, fr = lane & 15, fq = lane >> 4;
    const int K = g.K, nt = K / BK;
    unsigned voffA[2], voffB[2];
#pragma unroll
    for (int i = 0; i < 2; ++i) { int R, C; stage_rc(tid * 16 + i * 8192, R, C); const int Rb = (R & ~31) + perm32(R & 31);
        voffA[i] = (unsigned)(R * g.lda + C) * 2u; voffB[i] = (unsigned)(Rb * g.ldb + C) * 2u; }
    const size_t kstep = (size_t)(BK * 2);
    const size_t hstepA = (size_t)HALF * g.lda * 2, hstepB = (size_t)HALF * g.ldb * 2;
    const unsigned ldsw = (unsigned)wid * 1024u;
    const int aoff = lds_byte(wr * 64 + fr, fq * 8), boff = lds_byte(wc * 32 + fr, fq * 8);
#define PG8_SA(b, h) (((b) * 2 + (h)) * HTB)
#define PG8_SB(b, h) ((4 + (b) * 2 + (h)) * HTB)
#define PG8_STAGE(bufoff, gbase, voff) do { _Pragma("unroll") for (int _i = 0; _i < 2; ++_i) \
        __builtin_amdgcn_global_load_lds((const unsigned*)((const char*)(gbase) + (voff)[_i]), (LAS unsigned*)(lds + (bufoff) + ldsw + _i * 8192), 16, 0, 0); } while (0)
#define PG8_LDA(dst, b, h) do { _Pragma("unroll") for (int m = 0; m < 4; ++m) _Pragma("unroll") for (int k = 0; k < 2; ++k) dst[m][k] = *(const LAS bf16x8*)(lds + PG8_SA(b, h) + aoff + m * 2048 + k * 1024); } while (0)
#define PG8_LDB(dst, b, h) do { _Pragma("unroll") for (int n = 0; n < 2; ++n) _Pragma("unroll") for (int k = 0; k < 2; ++k) dst[n][k] = *(const LAS bf16x8*)(lds + PG8_SB(b, h) + boff + n * 2048 + k * 1024); } while (0)
#define PG8_MMA(ai, bj, At, Bt) do { __builtin_amdgcn_s_setprio(1); _Pragma("unroll") for (int m = 0; m < 4; ++m) _Pragma("unroll") for (int n = 0; n < 2; ++n) _Pragma("unroll") for (int k = 0; k < 2; ++k) \
        acc[ai][bj][m][n] = __builtin_amdgcn_mfma_f32_16x16x32_bf16(Bt[n][k], At[m][k], acc[ai][bj][m][n], 0, 0, 0); __builtin_amdgcn_s_setprio(0); } while (0)
#define PG8_WAIT_V(n) asm volatile("s_waitcnt vmcnt(" #n ")" ::: "memory")
#define PG8_WAIT_L(n) asm volatile("s_waitcnt lgkmcnt(" #n ")" ::: "memory")
#define PG8_BAR __builtin_amdgcn_s_barrier()
#define PG8_SCHED __builtin_amdgcn_sched_barrier(0)
    Unit cur, nxt; int ui = 0;
    if (!S.next(0, cur)) return;
    f32x4 acc[2][2][4][2];
#pragma unroll
    for (int a = 0; a < 2; ++a)
#pragma unroll
        for (int b = 0; b < 2; ++b)
#pragma unroll
            for (int m = 0; m < 4; ++m)
#pragma unroll
                for (int n = 0; n < 2; ++n) acc[a][b][m][n] = (f32x4){0.f, 0.f, 0.f, 0.f};
    bf16x8 At[4][2], B0[2][2], B1[2][2];
    const char* cA = cur.A; const char* cB = cur.B;
    PG8_STAGE(PG8_SB(0, 0), cB, voffB); PG8_STAGE(PG8_SB(0, 1), cB + hstepB, voffB); PG8_STAGE(PG8_SA(0, 0), cA, voffA); PG8_STAGE(PG8_SA(0, 1), cA + hstepA, voffA);
    if (wr == 1) PG8_BAR;
    PG8_WAIT_V(2); PG8_BAR;
    PG8_STAGE(PG8_SB(1, 0), cB + kstep, voffB); PG8_STAGE(PG8_SA(1, 0), cA + kstep, voffA); PG8_STAGE(PG8_SB(1, 1), cB + hstepB + kstep, voffB);
    PG8_WAIT_V(6); PG8_BAR;
    for (;;) {
        const bool has_next = S.next(ui + 1, nxt);
        const char* nA = has_next ? nxt.A : cA; const char* nB = has_next ? nxt.B : cB;
#pragma unroll 1
        for (int t = 0; t < nt; t += 2) {
            const bool last = (t == nt - 2);
            const char* a1 = cA + (size_t)(t + 1) * kstep;
            const char* a2 = last ? nA : cA + (size_t)(t + 2) * kstep; const char* b2 = last ? nB : cB + (size_t)(t + 2) * kstep;
            const char* a3 = a2 + kstep; const char* b3 = b2 + kstep;
            PG8_LDB(B0, 0, 0); PG8_LDB(B1, 0, 1); PG8_SCHED; PG8_LDA(At, 0, 0); PG8_STAGE(PG8_SA(1, 1), a1 + hstepA, voffA);
            PG8_WAIT_V(8); PG8_WAIT_L(0); PG8_BAR; PG8_MMA(0, 0, At, B0); PG8_MMA(0, 1, At, B1); PG8_BAR; PG8_SCHED;
            PG8_LDA(At, 0, 1); PG8_STAGE(PG8_SB(0, 0), b2, voffB); PG8_STAGE(PG8_SB(0, 1), b2 + hstepB, voffB); PG8_STAGE(PG8_SA(0, 0), a2, voffA);
            PG8_WAIT_V(8); PG8_WAIT_L(0); PG8_BAR; PG8_MMA(1, 0, At, B0); PG8_MMA(1, 1, At, B1); PG8_BAR; PG8_SCHED;
            PG8_LDB(B0, 1, 0); PG8_LDB(B1, 1, 1); PG8_SCHED; PG8_LDA(At, 1, 0); PG8_STAGE(PG8_SA(0, 1), a2 + hstepA, voffA);
            PG8_WAIT_V(8); PG8_WAIT_L(0); PG8_BAR; PG8_MMA(0, 0, At, B0); PG8_MMA(0, 1, At, B1); PG8_BAR; PG8_SCHED;
            PG8_LDA(At, 1, 1); PG8_STAGE(PG8_SB(1, 0), b3, voffB); PG8_STAGE(PG8_SB(1, 1), b3 + hstepB, voffB); PG8_STAGE(PG8_SA(1, 0), a3, voffA);
            PG8_WAIT_V(8); PG8_WAIT_L(0); PG8_BAR; PG8_MMA(1, 0, At, B0); PG8_MMA(1, 1, At, B1); PG8_BAR; PG8_SCHED;
        }
        if (wr == 0) PG8_BAR;
        E(acc, cur, wr, wc, fr, fq, lx);
        if (!has_next) break;
#pragma unroll
        for (int a = 0; a < 2; ++a)
#pragma unroll
            for (int b = 0; b < 2; ++b)
#pragma unroll
                for (int m = 0; m < 4; ++m)
#pragma unroll
                    for (int n = 0; n < 2; ++n) acc[a][b][m][n] = (f32x4){0.f, 0.f, 0.f, 0.f};
        cur = nxt; cA = nA; cB = nB; ++ui;
        if (wr == 1) PG8_BAR;
    }
    PG8_WAIT_V(0);
    PG8_BAR;
#undef PG8_SA
#undef PG8_SB
#undef PG8_STAGE
#undef PG8_LDA
#undef PG8_LDB
#undef PG8_MMA
#undef PG8_WAIT_V
#undef PG8_WAIT_L
#undef PG8_BAR
#undef PG8_SCHED
}
}
using pg8::Unit; using pg8::GemmP; using pg8::pack8;

namespace attn {
constexpr int AD = 128, NW = 8, QBLK = 32, KVBLK = 64, LD = PC;
constexpr float SCALE = 0.088388347648318440f;
constexpr float THR = 8.f;
constexpr size_t SHM_V = KVBLK * AD * 2, SHM_K = KVBLK * AD * 2, SHM_ATTN = 2 * SHM_V + 2 * SHM_K + NW * 64 * 4;
#define KSWZ(row, colB) ((row) * 256 + ((colB) ^ (((row) & 7) << 4)))
#define SBAR() __builtin_amdgcn_sched_barrier(0)
DI int crow(int r, int hi) { return (r & 3) + 8 * (r >> 2) + 4 * hi; }
DI void partialSM(f32x16& p0, f32x16& p1, float& m_reg, float& mn, float& alpha) {
  constexpr float C = SCALE * 1.4426950408889634f;
  float pmax = p0[0]; for (int r = 1; r < 16; ++r) pmax = fmaxf(pmax, p0[r]); for (int r = 0; r < 16; ++r) pmax = fmaxf(pmax, p1[r]);
  { auto rr = __builtin_amdgcn_permlane32_swap(__float_as_uint(pmax), __float_as_uint(pmax), false, false);
    pmax = fmaxf(__uint_as_float(rr[0]), __uint_as_float(rr[1])); }
  if (__builtin_expect(__all(pmax - m_reg <= THR / SCALE), 1)) { mn = m_reg; alpha = 1.f; }
  else { mn = fmaxf(m_reg, pmax); alpha = __builtin_amdgcn_exp2f((m_reg - mn) * C); m_reg = mn; }
  float mnC = -mn * C;
  for (int r = 0; r < 16; ++r) p0[r] = fmaf(p0[r], C, mnC); for (int r = 0; r < 16; ++r) p1[r] = fmaf(p1[r], C, mnC);
  for (int r = 0; r < 16; ++r) p0[r] = __builtin_amdgcn_exp2f(p0[r]);
}
DI void finishSM(f32x16& p0, f32x16& p1, float alpha, float& l_reg, bf16x8& pa0, bf16x8& pa1, bf16x8& pa2, bf16x8& pa3) {
  for (int r = 0; r < 16; ++r) p1[r] = __builtin_amdgcn_exp2f(p1[r]);
  float ps = 0; for (int r = 0; r < 16; ++r) ps += p0[r]; for (int r = 0; r < 16; ++r) ps += p1[r];
  { auto rr = __builtin_amdgcn_permlane32_swap(__float_as_uint(ps), __float_as_uint(ps), false, false);
    ps = __uint_as_float(rr[0]) + __uint_as_float(rr[1]); }
  l_reg = l_reg * alpha + ps;
#define PK4(P, BASE, OUT) do { unsigned a0 = cvt_pk_bf16(P[BASE + 0], P[BASE + 1]), a1 = cvt_pk_bf16(P[BASE + 2], P[BASE + 3]);   \
    unsigned b0 = cvt_pk_bf16(P[BASE + 4], P[BASE + 5]), b1 = cvt_pk_bf16(P[BASE + 6], P[BASE + 7]);                              \
    auto r0 = __builtin_amdgcn_permlane32_swap(a0, b0, false, false); auto r1 = __builtin_amdgcn_permlane32_swap(a1, b1, false, false); \
    u32x4 w = {r0[0], r1[0], r0[1], r1[1]}; OUT = *reinterpret_cast<bf16x8*>(&w); } while (0)
  PK4(p0, 0, pa0); PK4(p0, 8, pa1); PK4(p1, 0, pa2); PK4(p1, 8, pa3);
#undef PK4
}
DI void qkt(f32x16& p0, f32x16& p1, const bf16_t* Ks, const bf16x8* qr, int r32, int hi) {
  p0 = f32x16{}; p1 = f32x16{};
  for (int d0 = 0; d0 < 8; ++d0) { int cb = (d0 * 16 + hi * 8) * 2;
    bf16x8 b0 = *reinterpret_cast<const bf16x8*>((const char*)Ks + KSWZ(r32, cb));
    bf16x8 b1 = *reinterpret_cast<const bf16x8*>((const char*)Ks + KSWZ(32 + r32, cb));
    p0 = __builtin_amdgcn_mfma_f32_32x32x16_bf16(b0, qr[d0], p0, 0, 0, 0);
    p1 = __builtin_amdgcn_mfma_f32_32x32x16_bf16(b1, qr[d0], p1, 0, 0, 0); }
}
DI int v_st(int k, int c) { const int kk = (k & ~0xC) | ((k & 4) << 1) | ((k & 8) >> 1); return ((kk >> 3) * 4 + (c >> 5)) * 512 + ((kk & 7) * 32 + (c & 31)) * 2; }
DI int v_rd_base(int lane) { return ((lane & 3) << 3) | (((lane >> 2) & 3) << 6) | (((lane >> 4) & 1) << 5) | (((lane >> 5) & 1) << 8); }
constexpr int v_rd_off(int d0, int ks, int half) { return d0 * 512 + ks * 4096 + half * 2048; }
template <int OFF> DI s16x4 tr_read(int vb) {
  s16x4 r; asm volatile("ds_read_b64_tr_b16 %0, %1 offset:%2" : "=&v"(r) : "v"(vb), "i"(OFF) : "memory"); return r;
}
template <int D0> DI void pv_one(f32x16& od, int vb, bf16x8 pa0, bf16x8 pa1, bf16x8 pa2, bf16x8 pa3) {
  const s16x4 l0 = tr_read<v_rd_off(D0, 0, 0)>(vb), h0 = tr_read<v_rd_off(D0, 0, 1)>(vb), l1 = tr_read<v_rd_off(D0, 1, 0)>(vb), h1 = tr_read<v_rd_off(D0, 1, 1)>(vb);
  const s16x4 l2 = tr_read<v_rd_off(D0, 2, 0)>(vb), h2 = tr_read<v_rd_off(D0, 2, 1)>(vb), l3 = tr_read<v_rd_off(D0, 3, 0)>(vb), h3 = tr_read<v_rd_off(D0, 3, 1)>(vb);
  asm volatile("s_waitcnt lgkmcnt(0)" ::: "memory"); SBAR();
#define PK(L, H) (bf16x8){L[0], L[1], L[2], L[3], H[0], H[1], H[2], H[3]}
  od = __builtin_amdgcn_mfma_f32_32x32x16_bf16(pa0, PK(l0, h0), od, 0, 0, 0);
  od = __builtin_amdgcn_mfma_f32_32x32x16_bf16(pa1, PK(l1, h1), od, 0, 0, 0);
  od = __builtin_amdgcn_mfma_f32_32x32x16_bf16(pa2, PK(l2, h2), od, 0, 0, 0);
  od = __builtin_amdgcn_mfma_f32_32x32x16_bf16(pa3, PK(l3, h3), od, 0, 0, 0);
#undef PK
}
DI void pv_d0(f32x16* o, int vb, bf16x8 pa0, bf16x8 pa1, bf16x8 pa2, bf16x8 pa3) {
  pv_one<0>(o[0], vb, pa0, pa1, pa2, pa3); pv_one<1>(o[1], vb, pa0, pa1, pa2, pa3); pv_one<2>(o[2], vb, pa0, pa1, pa2, pa3); pv_one<3>(o[3], vb, pa0, pa1, pa2, pa3);
}
DI void attn_dense_body(int wave_, const bf16_t* __restrict__ Qb, const bf16_t* __restrict__ Kh, const bf16_t* __restrict__ Vh, bf16_t* Ob, int seq, char* lds) {
  const int tid = opaque_tid(wave_), wid = tid >> 6, lane = tid & 63, r32 = lane & 31, hi = lane >> 5;
  bf16_t* V_lds = (bf16_t*)lds; bf16_t* K_lds = (bf16_t*)(lds + 2 * SHM_V);
  float* ws = (float*)(lds + 2 * SHM_V + 2 * SHM_K) + wid * 64; float* li_l = ws; float* al_l = ws + 32;
  float m_reg = -1e30f, l_reg = 0; f32x16 o[4] = {}; bf16x8 qr[8];
  const bf16_t* Qw = Qb + (long)(wid * QBLK + r32) * LD + hi * 8;
#pragma unroll
  for (int d0 = 0; d0 < 8; ++d0) qr[d0] = *reinterpret_cast<const bf16x8*>(Qw + d0 * 16);
  const int sr = tid >> 4, sc = (tid & 15) * 8, vst0 = v_st(sr, sc), vst1 = v_st(32 + sr, sc);
  const int vb0 = (int)(uintptr_t)V_lds + v_rd_base(lane);
  struct { bf16x8 vs0, vs1, ks0, ks1; } sr_[2];
#define SLOAD(i, k0) do { sr_[i].vs0 = *(const bf16x8*)(&Vh[(long)((k0) + sr) * LD + sc]); sr_[i].vs1 = *(const bf16x8*)(&Vh[(long)((k0) + 32 + sr) * LD + sc]); \
    sr_[i].ks0 = *(const bf16x8*)(&Kh[(long)((k0) + sr) * LD + sc]); sr_[i].ks1 = *(const bf16x8*)(&Kh[(long)((k0) + 32 + sr) * LD + sc]); } while (0)
#define SWRITE(b, i) do { *(bf16x8*)((char*)V_lds + (b) * SHM_V + vst0) = sr_[i].vs0;          \
    *(bf16x8*)((char*)V_lds + (b) * SHM_V + vst1) = sr_[i].vs1; int kc = sc * 2;               \
    *(bf16x8*)((char*)K_lds + (b) * SHM_K + KSWZ(sr, kc)) = sr_[i].ks0;                       \
    *(bf16x8*)((char*)K_lds + (b) * SHM_K + KSWZ(32 + sr, kc)) = sr_[i].ks1; } while (0)
#define SWAIT() asm volatile("s_waitcnt vmcnt(4)" ::: "memory")
#define RESC(a) do { if (__any((a) < 1.f)) { if (hi == 0) al_l[r32] = (a); asm volatile("s_waitcnt lgkmcnt(0)" ::: "memory"); \
    for (int d = 0; d < 4; ++d) for (int r = 0; r < 16; ++r) o[d][r] *= al_l[crow(r, hi)]; } } while (0)
  f32x16 pA0, pA1, pB0, pB1; float mnA, mnB, alA, alB; bf16x8 pa0, pa1, pa2, pa3; const int NT = seq / KVBLK;
  constexpr int SE = 0, SO = 1;
  SLOAD(SE, 0); asm volatile("s_waitcnt vmcnt(0)" ::: "memory"); SWRITE(0, SE); __syncthreads();
  qkt(pA0, pA1, K_lds, qr, r32, hi); partialSM(pA0, pA1, m_reg, mnA, alA);
  SLOAD(SO, KVBLK); if (2 < NT) SLOAD(SE, 2 * KVBLK);
  SWAIT(); SWRITE(1, SO); __syncthreads();
  for (int j = 1; j + 1 < NT; j += 2) {
    SBAR(); qkt(pB0, pB1, (bf16_t*)((char*)K_lds + SHM_K), qr, r32, hi);
    finishSM(pA0, pA1, alA, l_reg, pa0, pa1, pa2, pa3); SBAR();
    SLOAD(SO, (j + 2) * KVBLK); SBAR();
    pv_d0(o, vb0, pa0, pa1, pa2, pa3); partialSM(pB0, pB1, m_reg, mnB, alB);
    __syncthreads(); SWAIT(); SWRITE(0, SE);
    RESC(alB); __syncthreads();
    SBAR(); qkt(pA0, pA1, K_lds, qr, r32, hi);
    finishSM(pB0, pB1, alB, l_reg, pa0, pa1, pa2, pa3); SBAR();
    if (j + 3 < NT) SLOAD(SE, (j + 3) * KVBLK); SBAR();
    pv_d0(o, vb0 + (int)SHM_V, pa0, pa1, pa2, pa3); partialSM(pA0, pA1, m_reg, mnA, alA);
    __syncthreads(); SWAIT(); SWRITE(1, SO);
    RESC(alA); __syncthreads();
  }
  SBAR(); qkt(pB0, pB1, (bf16_t*)((char*)K_lds + SHM_K), qr, r32, hi);
  finishSM(pA0, pA1, alA, l_reg, pa0, pa1, pa2, pa3); SBAR();
  pv_d0(o, vb0, pa0, pa1, pa2, pa3); partialSM(pB0, pB1, m_reg, mnB, alB);
  __syncthreads(); RESC(alB);
  finishSM(pB0, pB1, alB, l_reg, pa0, pa1, pa2, pa3); SBAR();
  pv_d0(o, vb0 + (int)SHM_V, pa0, pa1, pa2, pa3);
  if (hi == 0) li_l[r32] = l_reg; asm volatile("s_waitcnt lgkmcnt(0)" ::: "memory");
  float rli[16];
#pragma unroll
  for (int r = 0; r < 16; ++r) rli[r] = __builtin_amdgcn_rcpf(li_l[crow(r, hi)]);
  bf16_t* Ow = Ob + (long)(wid * QBLK) * LD;
#pragma unroll
  for (int r = 0; r < 16; ++r) { int orow = crow(r, hi);
    for (int d0 = 0; d0 < 4; ++d0) Ow[(long)orow * LD + d0 * 32 + r32] = f2bf(o[d0][r] * rli[r]); }
  asm volatile("s_waitcnt vmcnt(0) lgkmcnt(0)" ::: "memory"); __syncthreads();
#undef SLOAD
#undef SWRITE
#undef SWAIT
#undef RESC
}
}

struct Inputs {
    const float *x_prompt, *x_sample, *mem_prompt, *mem_sample, *g_mix_pre, *g_mix_post, *w_in, *hy_conv, *hy_fw1, *hy_fb1, *hy_fw2, *hy_fb2, *hy_fw3, *hy_bias,
                *ret_decay, *att_qnorm, *att_knorm, *w_branch, *w_out, *g_x_pre, *g_x_post, *g_mem, *w_xq, *w_xkv, *w_xo, *g_ff_pre, *g_ff_post, *w_ff1, *w_ff2;
};
struct Args { Inputs in; float* out; unsigned char* ws; int ph_lo, ph_hi; };

DI void transpose_item(const float* W, int K, int N, bf16_t* WT, int item, LAS float* scr, int lane) {
    const int nblk = N / 32, kb = item / nblk, nb = item % nblk, k0 = 64 * kb, n0 = 32 * nb;
    float tv[32];
#pragma unroll
    for (int i = 0; i < 32; ++i) { const int kk = 2 * i + (lane >> 5); tv[i] = __builtin_nontemporal_load(W + (size_t)(k0 + kk) * N + n0 + (lane & 31)); }
#pragma unroll
    for (int i = 0; i < 32; ++i) { const int kk = 2 * i + (lane >> 5); scr[kk * 33 + (lane & 31)] = tv[i]; }
    LDS_WAIT();
    const int c = lane & 7;
#pragma unroll
    for (int j = 0; j < 4; ++j) { const int n = (lane >> 3) + 8 * j; const LAS float* s = scr + (8 * c) * 33 + n;
        u32x4 o; o.x = cvt_pk_bf16(s[0 * 33], s[1 * 33]); o.y = cvt_pk_bf16(s[2 * 33], s[3 * 33]); o.z = cvt_pk_bf16(s[4 * 33], s[5 * 33]); o.w = cvt_pk_bf16(s[6 * 33], s[7 * 33]);
        *(u32x4*)(WT + (size_t)(n0 + n) * K + k0 + 8 * c) = o; }
    LDS_WAIT();
}
DI void convert_weights(const Inputs& in, int l, unsigned char* ws, LAS unsigned char* lds, int gw, int NGW, int wave, int lane) {
    LAS float* scr = (LAS float*)(lds + wave * 16384);
    unsigned char* wb = ws + WS_WB;
    constexpr int I_IN = 16 * 240, I_BR = 8 * 32, I_SQ = 16 * 32, I_KV = 16 * 64, I_F1 = 16 * 128, I_F2 = 64 * 32;
    for (int it = gw; it < I_IN; it += NGW) transpose_item(in.w_in + (size_t)l * 1024 * INC, 1024, INC, (bf16_t*)(wb + WB_IN), it, scr, lane);
    for (int it = gw; it < 3 * I_BR; it += NGW) { const int br = it / I_BR; transpose_item(in.w_branch + (size_t)l * 1536 * 1024 + (size_t)br * 512 * 1024, 512, 1024, (bf16_t*)(wb + WB_BR) + (size_t)br * 1024 * 512, it % I_BR, scr, lane); }
    for (int it = gw; it < I_SQ; it += NGW) transpose_item(in.w_out + (size_t)l * 1024 * 1024, 1024, 1024, (bf16_t*)(wb + WB_OUT), it, scr, lane);
    for (int it = gw; it < I_SQ; it += NGW) transpose_item(in.w_xq + (size_t)l * 1024 * 1024, 1024, 1024, (bf16_t*)(wb + WB_XQ), it, scr, lane);
    for (int it = gw; it < I_KV; it += NGW) transpose_item(in.w_xkv + (size_t)l * 1024 * 2048, 1024, 2048, (bf16_t*)(wb + WB_XKV), it, scr, lane);
    for (int it = gw; it < I_SQ; it += NGW) transpose_item(in.w_xo + (size_t)l * 1024 * 1024, 1024, 1024, (bf16_t*)(wb + WB_XO), it, scr, lane);
    for (int it = gw; it < I_F1; it += NGW) transpose_item(in.w_ff1 + (size_t)l * 1024 * 4096, 1024, 4096, (bf16_t*)(wb + WB_F1), it, scr, lane);
    for (int it = gw; it < I_F2; it += NGW) transpose_item(in.w_ff2 + (size_t)l * 4096 * 1024, 4096, 1024, (bf16_t*)(wb + WB_F2), it, scr, lane);
}

template <bool XIN_BF, bool XOUT_BF>
DI void norm_row(const void* xin, const bf16_t* Rrow, const float* gpost, void* xout, const float* gpre, bf16_t* xn, int lane) {
    f32x4 v[4];
#pragma unroll
    for (int j = 0; j < 4; ++j) {
        if (XIN_BF) { const u32x2 w = *(const u32x2*)((const bf16_t*)xin + 4 * lane + 256 * j); v[j] = (f32x4){bflo(w.x), bfhi(w.x), bflo(w.y), bfhi(w.y)}; }
        else v[j] = *(const f32x4*)((const float*)xin + 4 * lane + 256 * j); }
    if (Rrow) {
        f32x4 r[4]; float ss = 0.f;
#pragma unroll
        for (int j = 0; j < 4; ++j) { const u32x2 w = *(const u32x2*)(Rrow + 4 * lane + 256 * j); r[j] = (f32x4){bflo(w.x), bfhi(w.x), bflo(w.y), bfhi(w.y)};
            ss += (r[j][0] * r[j][0] + r[j][1] * r[j][1]) + (r[j][2] * r[j][2] + r[j][3] * r[j][3]); }
        const float rinv = __builtin_amdgcn_rsqf(wave_sum(ss) * (1.f / 1024.f) + EPS);
#pragma unroll
        for (int j = 0; j < 4; ++j) { const f32x4 g = *(const f32x4*)(gpost + 4 * lane + 256 * j); v[j] += r[j] * rinv * g; }
    }
    if (xout) {
#pragma unroll
        for (int j = 0; j < 4; ++j) {
            if (XOUT_BF) { u32x2 w; w.x = cvt_pk_bf16(v[j][0], v[j][1]); w.y = cvt_pk_bf16(v[j][2], v[j][3]); *(u32x2*)((bf16_t*)xout + 4 * lane + 256 * j) = w;
                           v[j] = (f32x4){bflo(w.x), bfhi(w.x), bflo(w.y), bfhi(w.y)}; }
            else *(f32x4*)((float*)xout + 4 * lane + 256 * j) = v[j]; }
    }
    if (xn) {
        float ss = 0.f;
#pragma unroll
        for (int j = 0; j < 4; ++j) ss += (v[j][0] * v[j][0] + v[j][1] * v[j][1]) + (v[j][2] * v[j][2] + v[j][3] * v[j][3]);
        const float rinv = __builtin_amdgcn_rsqf(wave_sum(ss) * (1.f / 1024.f) + EPS);
#pragma unroll
        for (int j = 0; j < 4; ++j) { const f32x4 g = *(const f32x4*)(gpre + 4 * lane + 256 * j); const f32x4 o = v[j] * rinv * g;
            u32x2 w; w.x = cvt_pk_bf16(o[0], o[1]); w.y = cvt_pk_bf16(o[2], o[3]); *(u32x2*)(xn + 4 * lane + 256 * j) = w; }
    }
}

template <bool XOUT_BF, int NR>
DI void norm_rows(const bf16_t* xin, const bf16_t* Rb, const float* gpost, void* xout, const float* gpre, bf16_t* xnb, size_t row0, size_t rstride, int lane) {
    f32x4 v[NR][4], r[NR][4];
#pragma unroll
    for (int q = 0; q < NR; ++q)
#pragma unroll
        for (int j = 0; j < 4; ++j) { const size_t off = (row0 + q * rstride) * D + 4 * lane + 256 * j;
            const u32x2 w = __builtin_nontemporal_load((const u32x2*)(xin + off)); v[q][j] = (f32x4){bflo(w.x), bfhi(w.x), bflo(w.y), bfhi(w.y)};
            const u32x2 w2 = __builtin_nontemporal_load((const u32x2*)(Rb + off)); r[q][j] = (f32x4){bflo(w2.x), bfhi(w2.x), bflo(w2.y), bfhi(w2.y)}; }
    float ss[NR], s2[NR];
#pragma unroll
    for (int q = 0; q < NR; ++q) { ss[q] = 0.f; s2[q] = 0.f;
#pragma unroll
        for (int j = 0; j < 4; ++j) ss[q] += (r[q][j][0] * r[q][j][0] + r[q][j][1] * r[q][j][1]) + (r[q][j][2] * r[q][j][2] + r[q][j][3] * r[q][j][3]); }
#pragma unroll
    for (int o = 1; o < 64; o <<= 1)
#pragma unroll
        for (int q = 0; q < NR; ++q) ss[q] += __shfl_xor(ss[q], o);
#pragma unroll
    for (int q = 0; q < NR; ++q) { const float rinv = __builtin_amdgcn_rsqf(ss[q] * (1.f / 1024.f) + EPS);
#pragma unroll
        for (int j = 0; j < 4; ++j) { const size_t off = (row0 + q * rstride) * D + 4 * lane + 256 * j;
            const f32x4 g = *(const f32x4*)(gpost + 4 * lane + 256 * j); v[q][j] += r[q][j] * rinv * g;
            if (XOUT_BF) { u32x2 w; w.x = cvt_pk_bf16(v[q][j][0], v[q][j][1]); w.y = cvt_pk_bf16(v[q][j][2], v[q][j][3]); __builtin_nontemporal_store(w, (u32x2*)((bf16_t*)xout + off));
                           v[q][j] = (f32x4){bflo(w.x), bfhi(w.x), bflo(w.y), bfhi(w.y)}; }
            else *(f32x4*)((float*)xout + off) = v[q][j];
            s2[q] += (v[q][j][0] * v[q][j][0] + v[q][j][1] * v[q][j][1]) + (v[q][j][2] * v[q][j][2] + v[q][j][3] * v[q][j][3]); } }
    if (xnb) {
#pragma unroll
        for (int o = 1; o < 64; o <<= 1)
#pragma unroll
            for (int q = 0; q < NR; ++q) s2[q] += __shfl_xor(s2[q], o);
#pragma unroll
        for (int q = 0; q < NR; ++q) { const float rinv = __builtin_amdgcn_rsqf(s2[q] * (1.f / 1024.f) + EPS);
#pragma unroll
            for (int j = 0; j < 4; ++j) { const size_t off = (row0 + q * rstride) * D + 4 * lane + 256 * j;
                const f32x4 g = *(const f32x4*)(gpre + 4 * lane + 256 * j); const f32x4 o = v[q][j] * rinv * g;
                u32x2 w; w.x = cvt_pk_bf16(o[0], o[1]); w.y = cvt_pk_bf16(o[2], o[3]); *(u32x2*)(xnb + off) = w; } }
    }
}

DI void make_tables(unsigned char* ws, int gtid, int NT) {
    float* rtc = (float*)(ws + WS_RTC); float* rts = (float*)(ws + WS_RTS); float* axc = (float*)(ws + WS_AXC); float* axs = (float*)(ws + WS_AXS);
    const double TWO_PI = 6.283185307179586476925286766559;
    for (int i = gtid; i < 4096 * 64 + 64 * 32; i += NT) {
        int pos, fi; double inv;
        if (i < 4096 * 64) { pos = i >> 6; fi = i & 63; inv = exp(-9.210340371976182736 * (double)fi / 64.0); }
        else { const int j = i - 4096 * 64; pos = j >> 5; fi = j & 31; inv = exp(-9.210340371976182736 * (double)fi / 32.0); }
        const double ang = (double)pos * inv; const double red = ang - TWO_PI * rint(ang / TWO_PI);
        const float c = __cosf((float)red), s = __sinf((float)red);
        if (i < 4096 * 64) { rtc[i] = c; rts[i] = s; } else { axc[i - 4096 * 64] = c; axs[i - 4096 * 64] = s; }
    }
}

DI void filter_gen(const Inputs& in, int l, unsigned char* ws, LAS unsigned char* lds, int vcu, int G, int wave, int tid) {
    const float* w1 = in.hy_fw1 + (size_t)l * 33 * 64; const float* b1 = in.hy_fb1 + l * 64; const float* w2 = in.hy_fw2 + (size_t)l * 64 * 64; const float* b2 = in.hy_fb2 + l * 64;
    const float* w3 = in.hy_fw3 + (size_t)l * 64 * 1024;
    const int lane = tid & 63, chunk = vcu & 3, wgi = vcu >> 2, nwg = (G + 3 - chunk) >> 2;
    LAS float* W3s = (LAS float*)lds; LAS float* W1s = (LAS float*)(lds + 65536); LAS float* W2s = (LAS float*)(lds + 65536 + 8448); LAS float* Bs = (LAS float*)(lds + 65536 + 8448 + 16384);
    __syncthreads();
    { f32x4 t3[8];
#pragma unroll
      for (int k = 0; k < 8; ++k) { const int i = tid + 512 * k; t3[k] = *(const f32x4*)(w3 + (i >> 6) * 1024 + 256 * chunk + (i & 63) * 4); }
      f32x4 t2[2], t1[2];
#pragma unroll
      for (int k = 0; k < 2; ++k) { const int i = tid + 512 * k; t2[k] = *(const f32x4*)(w2 + i * 4); t1[k] = i < 528 ? *(const f32x4*)(w1 + i * 4) : (f32x4){0.f, 0.f, 0.f, 0.f}; }
#pragma unroll
      for (int k = 0; k < 8; ++k) { const int i = tid + 512 * k; *(LAS f32x4*)(W3s + (i >> 6) * 256 + (i & 63) * 4) = t3[k]; }
#pragma unroll
      for (int k = 0; k < 2; ++k) { const int i = tid + 512 * k; *(LAS f32x4*)(W2s + i * 4) = t2[k]; if (i < 528) *(LAS f32x4*)(W1s + i * 4) = t1[k]; } }
    if (tid < 64) Bs[tid] = b1[tid]; else if (tid < 128) Bs[tid] = b2[tid - 64];
    __syncthreads();
    for (int it = wgi * 8 + wave; it < 4096 + 2048; it += nwg * 8) {
        const int g = it >= 4096, t = g ? it - 4096 : it, L = g ? 2048 : 4096, FRS = g ? FRS1 : FRS0;
        bf16_t* FR = (bf16_t*)(ws + (g ? WS_FR1 : WS_FR0)); bf16_t* FRO = (bf16_t*)(ws + (g ? WS_FRO1 : WS_FRO0));
        const float tl = (float)t / (float)(L - 1);
        const float w = 6.2831853071795864769f * (float)t / (float)L;
        float z;
        { const int k = lane; const int fi = (k >= 17) ? k - 17 : k - 1; const float f = 1e-4f + (float)fi * ((15.0f - 1e-4f) / 15.0f);
          z = (k == 0) ? tl : (k <= 16 ? __cosf(f * w) : -__sinf(f * w)); if (k > 32) z = 0.f; }
        float a = Bs[lane];
#pragma unroll 11
        for (int k = 0; k < 33; ++k) a += __shfl(z, k) * W1s[k * 64 + lane];
        const float h1 = __sinf(a);
        a = Bs[64 + lane];
#pragma unroll 16
        for (int k = 0; k < 64; ++k) a += __shfl(h1, k) * W2s[k * 64 + lane];
        const float h2 = __sinf(a);
        float o[4] = {0.f, 0.f, 0.f, 0.f};
#pragma unroll 16
        for (int k = 0; k < 64; ++k) { const float hk = __shfl(h2, k);
#pragma unroll
            for (int q = 0; q < 4; ++q) o[q] += hk * W3s[k * 256 + lane + 64 * q]; }
#pragma unroll
        for (int q = 0; q < 4; ++q) {
            const int cidx = 256 * chunk + lane + 64 * q, dir = cidx >> 9, c = cidx & 511;
            const float delta = fabsf(-3.0701134573253942f + (float)c * ((-15.350567286626972f + 3.0701134573253942f) / 511.0f));
            const float val = o[q] * __expf(-tl * delta);
            bf16_t* row = FR + (size_t)c * FRS; bf16_t* rowo = FRO + (size_t)c * FRS;
            if (dir == 0) { row[L - t] = f2bf(val); rowo[L - t - 1] = f2bf(val); }
            else if (t >= 1) { row[L + t] = f2bf(val); rowo[L + t - 1] = f2bf(val); }
        }
    }
    __syncthreads();
}

DI void prep_attn(const Inputs& in, int l, unsigned char* ws, int half, int gw, int NGW, int lane) {
    constexpr int NTK = 4;
    bf16_t* proj = (bf16_t*)(ws + WS_PROJ); const float* axc = (const float*)(ws + WS_AXC); const float* axs = (const float*)(ws + WS_AXS);
    const int L = half ? 2048 : 4096;
    const int d1 = lane < 32 ? lane : 64 + (lane - 32), d2 = d1 + 32, fi = lane & 31;
    const float gq1 = in.att_qnorm[l * 128 + d1], gq2 = in.att_qnorm[l * 128 + d2], gk1 = in.att_knorm[l * 128 + d1], gk2 = in.att_knorm[l * 128 + d2];
    for (int tok0 = gw; tok0 < HT; tok0 += NTK * NGW) {
        float x1[NTK][6], x2[NTK][6], c[NTK], sn[NTK];
#pragma unroll
        for (int k = 0; k < NTK; ++k) { const int tok = tok0 + k * NGW < HT ? tok0 + k * NGW : tok0, t = tok % L; const int pos = lane < 32 ? (t >> 6) : (t & 63);
            c[k] = axc[pos * 32 + fi]; sn[k] = axs[pos * 32 + fi];
            const bf16_t* row = proj + (size_t)tok * PC;
#pragma unroll
            for (int v = 0; v < 6; ++v) { const int base = v < 4 ? C_AQ + 128 * v : C_AK + 128 * (v - 4); x1[k][v] = bf2f(row[base + d1]); x2[k][v] = bf2f(row[base + d2]); } }
        float ss[NTK][6];
#pragma unroll
        for (int k = 0; k < NTK; ++k)
#pragma unroll
            for (int v = 0; v < 6; ++v) ss[k][v] = x1[k][v] * x1[k][v] + x2[k][v] * x2[k][v];
#pragma unroll
        for (int o = 1; o < 64; o <<= 1)
#pragma unroll
            for (int k = 0; k < NTK; ++k)
#pragma unroll
                for (int v = 0; v < 6; ++v) ss[k][v] += __shfl_xor(ss[k][v], o);
#pragma unroll
        for (int k = 0; k < NTK; ++k) { if (tok0 + k * NGW < HT) { bf16_t* row = proj + (size_t)(tok0 + k * NGW) * PC;
#pragma unroll
            for (int v = 0; v < 6; ++v) { const int base = v < 4 ? C_AQ + 128 * v : C_AK + 128 * (v - 4);
                const float rinv = __builtin_amdgcn_rsqf(ss[k][v] * (1.f / 128.f) + EPS);
                const float y1 = x1[k][v] * rinv * (v < 4 ? gq1 : gk1), y2 = x2[k][v] * rinv * (v < 4 ? gq2 : gk2);
                row[base + d1] = f2bf(y1 * c[k] - y2 * sn[k]); row[base + d2] = f2bf(y1 * sn[k] + y2 * c[k]); } } }
    }
}

DI void prep_hyena(const Inputs& in, int l, unsigned char* ws, int half, int vcu, int G, int tid) {
    const bf16_t* proj = (const bf16_t*)(ws + WS_PROJ); bf16_t* ZT = (bf16_t*)(ws + WS_ZT); bf16_t* X0T = (bf16_t*)(ws + WS_X0T);
    const int L = half ? 2048 : 4096, ntb = L / 64;
    const float* cw = in.hy_conv + (size_t)l * 3 * 1536;
    const int cch = tid & 127, tq = tid >> 7, c0 = 4 * cch;
    f32x4 w[3][3];
#pragma unroll
    for (int j = 0; j < 3; ++j)
#pragma unroll
        for (int sg = 0; sg < 3; ++sg) w[j][sg] = *(const f32x4*)(cw + j * 1536 + sg * 512 + c0);
    for (int tile = vcu; tile < HT / 64; tile += G) {
        const int s = tile / ntb, tb = tile % ntb;
        const bf16_t* base = proj + (size_t)(s * L) * PC + c0;
#pragma unroll 1
        for (int hb = 0; hb < 2; ++hb) {
            const int t0 = tb * 64 + (tq + 4 * hb) * 8;
            u32x2 rw[10][3];
#pragma unroll
            for (int r = 0; r < 10; ++r)
#pragma unroll
                for (int sg = 0; sg < 3; ++sg) { const int t = t0 - 1 + r; rw[r][sg] = (u32x2){0u, 0u}; if (t >= 0 && t < L) rw[r][sg] = *(const u32x2*)(base + (size_t)t * PC + sg * 512); }
            unsigned zt[4][4], xt[4][4];
            f32x4 zprev, xprev;
#pragma unroll
            for (int k = 0; k < 8; ++k) {
                f32x4 u[3];
#pragma unroll
                for (int sg = 0; sg < 3; ++sg) { const u32x2 pv = rw[k][sg], cu = rw[k + 1][sg], nx = rw[k + 2][sg];
                    const f32x4 a = {bflo(pv.x), bfhi(pv.x), bflo(pv.y), bfhi(pv.y)}, b = {bflo(cu.x), bfhi(cu.x), bflo(cu.y), bfhi(cu.y)}, c = {bflo(nx.x), bfhi(nx.x), bflo(nx.y), bfhi(nx.y)};
                    u[sg] = a * w[0][sg] + b * w[1][sg] + c * w[2][sg]; }
                const f32x4 z = u[2] * u[1], x = u[0];
                if (k & 1) {
#pragma unroll
                    for (int e = 0; e < 4; ++e) { zt[e][k >> 1] = cvt_pk_bf16(zprev[e], z[e]); xt[e][k >> 1] = cvt_pk_bf16(xprev[e], x[e]); } }
                else { zprev = z; xprev = x; }
            }
#pragma unroll
            for (int e = 0; e < 4; ++e) { const size_t off = (size_t)(s * 512 + c0 + e) * L + t0;
                *(u32x4*)(ZT + off) = (u32x4){zt[e][0], zt[e][1], zt[e][2], zt[e][3]}; *(u32x4*)(X0T + off) = (u32x4){xt[e][0], xt[e][1], xt[e][2], xt[e][3]}; }
        }
    }
}
DI void post_hyena(unsigned char* ws, int half, LAS unsigned char* lds, int vcu, int G, int tid) {
    bf16_t* proj = (bf16_t*)(ws + WS_PROJ); const bf16_t* YT = (const bf16_t*)(ws + WS_X0T);
    const int L = half ? 2048 : 4096, ntb = L / 64;
    LAS bf16_t* Ts = (LAS bf16_t*)lds;
    for (int tile = vcu; tile < (HT / 64) * 8; tile += G) {
        const int cb = tile & 7, tbg = tile >> 3, s = tbg / ntb, tb = tbg % ntb;
        { const int c2 = tid >> 3, ch = tid & 7; *(LAS u32x4*)(Ts + c2 * 72 + 8 * ch) = *(const u32x4*)(YT + (size_t)(s * 512 + cb * 64 + c2) * L + tb * 64 + 8 * ch); }
        __syncthreads();
        { const int t2 = tid >> 3, ch = tid & 7; unsigned short e[8];
#pragma unroll
          for (int k = 0; k < 8; ++k) e[k] = Ts[(8 * ch + k) * 72 + t2];
          u32x4 o; o.x = e[0] | ((unsigned)e[1] << 16); o.y = e[2] | ((unsigned)e[3] << 16); o.z = e[4] | ((unsigned)e[5] << 16); o.w = e[6] | ((unsigned)e[7] << 16);
          *(u32x4*)(proj + (size_t)(s * L + tb * 64 + t2) * PC + C_YH + cb * 64 + 8 * ch) = o; }
        __syncthreads();
    }
}

DI void hyena_unit(const Inputs& in, int l, unsigned char* ws, int half, int c, LAS unsigned char* lds, int tid) {
    const int L = half ? 2048 : 4096, NB = half ? 8 : 4, nblk = L / 32, FRS = half ? FRS1 : FRS0, ZS = L + 2048, ZSP = (ZS / 32) * 40;
    const bf16_t* FR = (const bf16_t*)(ws + (half ? WS_FR1 : WS_FR0)) + (size_t)c * FRS; const bf16_t* FRO = (const bf16_t*)(ws + (half ? WS_FRO1 : WS_FRO0)) + (size_t)c * FRS;
    const bf16_t* ZT = (const bf16_t*)(ws + WS_ZT); bf16_t* XT = (bf16_t*)(ws + WS_X0T);
    constexpr int FRB = 16640;
    LAS unsigned char* Zl = lds + 2 * FRB;
    const int cpr = ZS / 8, nfr = (2 * L + 64) / 8;
    { u32x4 fv[5], zv[8];
#pragma unroll
      for (int k = 0; k < 5; ++k) { const int i = tid + 512 * k, cp = i >= nfr, kk = cp ? i - nfr : i; fv[k] = (u32x4){0u, 0u, 0u, 0u};
          if (i < 2 * nfr && kk < 2 * L / 8) fv[k] = *(const u32x4*)((cp ? FRO : FR) + kk * 8);
          if (cp && kk == 2 * L / 8 - 1) fv[k].w &= 0xffffu; }
#pragma unroll
      for (int k = 0; k < 8; ++k) { const int i = tid + 512 * k, b = i / cpr, j = i % cpr, m = j * 8 - 1024; zv[k] = (u32x4){0u, 0u, 0u, 0u};
          if (i < NB * cpr && m >= 0 && m < L) zv[k] = *(const u32x4*)(ZT + (size_t)(b * 512 + c) * L + m); }
#pragma unroll
      for (int k = 0; k < 5; ++k) { const int i = tid + 512 * k, cp = i >= nfr, kk = cp ? i - nfr : i; if (i < 2 * nfr) *(LAS u32x4*)(lds + cp * FRB + kk * 16) = fv[k]; }
#pragma unroll
      for (int k = 0; k < 8; ++k) { const int i = tid + 512 * k, b = i / cpr, j = i % cpr; if (i < NB * cpr) *(LAS u32x4*)(Zl + ((size_t)b * ZSP + (j >> 2) * 40 + (j & 3) * 8) * 2) = zv[k]; } }
    __syncthreads();
    const int wave = tid >> 6, lane = tid & 63, i32 = lane & 31, g = lane >> 5;
    const int gpb = nblk / 32, a0 = 32 * (wave % gpb), b0 = 2 * (wave / gpb);
    const int dlo = a0 - nblk + 1, dhi = a0 + 31;
    f32x16 acc0 = {}, acc1 = {};
    const LAS unsigned char* Zb = Zl + (size_t)b0 * ZSP * 2;
    const int zstep = ZSP * 2;
    int s0 = L - 32 * dlo - i32 + 8 * g;
    const LAS unsigned char* zp0 = Zb + ((32 + a0 + i32 - dlo) * 40 + 8 * g) * 2;
#define HY_A(jh) ({ const int s_ = s0 + 16 * (jh); const LAS unsigned* p_ = (const LAS unsigned*)(lds + (s_ & 1) * FRB) + (s_ >> 1); \
        u32x4 aw_; aw_.x = p_[0]; aw_.y = p_[1]; aw_.z = p_[2]; aw_.w = p_[3]; __builtin_bit_cast(bf16x8, aw_); })
#define HY_B(gi, jh) (*(const LAS bf16x8*)(zp0 + (gi) * zstep + (jh) * 32))
    for (int d = dlo; d <= dhi; ++d) {
#pragma unroll
        for (int jh = 0; jh < 2; ++jh) { const bf16x8 a = HY_A(jh);
            acc0 = __builtin_amdgcn_mfma_f32_32x32x16_bf16(a, HY_B(0, jh), acc0, 0, 0, 0);
            acc1 = __builtin_amdgcn_mfma_f32_32x32x16_bf16(a, HY_B(1, jh), acc1, 0, 0, 0); }
        s0 -= 32; zp0 -= 80;
    }
#undef HY_A
#undef HY_B
    const float bias = in.hy_bias[l * 512 + c];
    u32x2 xx[2][4];
#pragma unroll
    for (int k = 0; k < 2; ++k)
#pragma unroll
        for (int q = 0; q < 4; ++q) xx[k][q] = *(const u32x2*)(XT + (size_t)((b0 + k) * 512 + c) * L + 32 * (a0 + i32) + 8 * q + 4 * g);
#pragma unroll
    for (int k = 0; k < 2; ++k) {
        const int a = a0 + i32, b = b0 + k;
#pragma unroll
        for (int q = 0; q < 4; ++q) {
            const int t0 = 32 * a + 8 * q + 4 * g;
            const u32x2 zz = *(const LAS u32x2*)(Zb + k * zstep + ((32 + a) * 40 + 8 * q + 4 * g) * 2);
            bf16_t* xp = XT + (size_t)(b * 512 + c) * L + t0;
            const float z0 = bflo(zz.x), z1 = bfhi(zz.x), z2 = bflo(zz.y), z3 = bfhi(zz.y);
            const float x0 = bflo(xx[k][q].x), x1 = bfhi(xx[k][q].x), x2 = bflo(xx[k][q].y), x3 = bfhi(xx[k][q].y);
            const float c0 = k ? acc1[4 * q + 0] : acc0[4 * q + 0], c1 = k ? acc1[4 * q + 1] : acc0[4 * q + 1], c2 = k ? acc1[4 * q + 2] : acc0[4 * q + 2], c3 = k ? acc1[4 * q + 3] : acc0[4 * q + 3];
            u32x2 o; o.x = cvt_pk_bf16((c0 + z0 * bias) * x0, (c1 + z1 * bias) * x1); o.y = cvt_pk_bf16((c2 + z2 * bias) * x2, (c3 + z3 * bias) * x3);
            *(u32x2*)xp = o;
        }
    }
    __syncthreads();
}

namespace ret {
constexpr int TS = 136, TILE_B = 128 * TS * 2;
DI float logsig(float x) { return -log1pf(__expf(-x)); }
DI void unpack8(const u32x4 w, float (&f)[8]) { f[0] = bflo(w.x); f[1] = bfhi(w.x); f[2] = bflo(w.y); f[3] = bfhi(w.y); f[4] = bflo(w.z); f[5] = bfhi(w.z); f[6] = bflo(w.w); f[7] = bfhi(w.w); }
DI int sw(int row, int col) { return row * TS + ((((col >> 3) ^ (row >> 3)) & 15) << 3) + (col & 7); }
DI void rot_item(const bf16_t* src, const float* rtc, const float* rts, int pos0, int j, int d0, float (&o1)[8], float (&o2)[8]) {
    float x1[8], x2[8]; unpack8(*(const u32x4*)(src + (size_t)j * PC + d0), x1); unpack8(*(const u32x4*)(src + (size_t)j * PC + 64 + d0), x2);
    const float* cp = rtc + (size_t)(pos0 + j) * 64 + d0; const float* sp = rts + (size_t)(pos0 + j) * 64 + d0;
    const f32x4 ca = *(const f32x4*)cp, cb = *(const f32x4*)(cp + 4), sa = *(const f32x4*)sp, sb = *(const f32x4*)(sp + 4);
#pragma unroll
    for (int e = 0; e < 8; ++e) { const float c = e < 4 ? ca[e & 3] : cb[e & 3], s = e < 4 ? sa[e & 3] : sb[e & 3]; o1[e] = x1[e] * c - x2[e] * s; o2[e] = x1[e] * s + x2[e] * c; }
}
DI void stage_rot_rm(LAS unsigned char* dst, const bf16_t* src, const float* rtc, const float* rts, int pos0, float scale, int tid) {
    for (int it = tid; it < 1024; it += 512) { const int j = it >> 3, d0 = (it & 7) * 8; float o1[8], o2[8]; rot_item(src, rtc, rts, pos0, j, d0, o1, o2);
        u32x4 w1, w2; w1.x = cvt_pk_bf16(o1[0] * scale, o1[1] * scale); w1.y = cvt_pk_bf16(o1[2] * scale, o1[3] * scale); w1.z = cvt_pk_bf16(o1[4] * scale, o1[5] * scale); w1.w = cvt_pk_bf16(o1[6] * scale, o1[7] * scale);
        w2.x = cvt_pk_bf16(o2[0] * scale, o2[1] * scale); w2.y = cvt_pk_bf16(o2[2] * scale, o2[3] * scale); w2.z = cvt_pk_bf16(o2[4] * scale, o2[5] * scale); w2.w = cvt_pk_bf16(o2[6] * scale, o2[7] * scale);
        *(LAS u32x4*)(dst + sw(j, d0) * 2) = w1; *(LAS u32x4*)(dst + sw(j, 64 + d0) * 2) = w2; }
}
DI void stage_rot_T2(LAS unsigned char* dF, LAS unsigned char* dB, const bf16_t* src, const float* rtc, const float* rts, int pos0, float scale, float lgf, float lgb, int tid) {
    LAS bf16_t* F = (LAS bf16_t*)dF; LAS bf16_t* B = (LAS bf16_t*)dB;
    for (int it = tid; it < 1024; it += 512) { const int j = it >> 3, d0 = (it & 7) * 8; float o1[8], o2[8]; rot_item(src, rtc, rts, pos0, j, d0, o1, o2);
        const float wf = __expf((float)(127 - j) * lgf) * scale, wb = __expf((float)j * lgb) * scale;
#pragma unroll
        for (int e = 0; e < 8; ++e) { const int i1 = sw(d0 + e, j), i2 = sw(64 + d0 + e, j); F[i1] = f2bf(o1[e] * wf); F[i2] = f2bf(o2[e] * wf); B[i1] = f2bf(o1[e] * wb); B[i2] = f2bf(o2[e] * wb); } }
}
struct RotIn { u32x4 a, b; f32x4 ca, cb, sa, sb; };
DI RotIn rot_load(const bf16_t* src, const float* rtc, const float* rts, int pos0, int j, int d0) {
    RotIn r; r.a = *(const u32x4*)(src + (size_t)j * PC + d0); r.b = *(const u32x4*)(src + (size_t)j * PC + 64 + d0);
    const float* cp = rtc + (size_t)(pos0 + j) * 64 + d0; const float* sp = rts + (size_t)(pos0 + j) * 64 + d0;
    r.ca = *(const f32x4*)cp; r.cb = *(const f32x4*)(cp + 4); r.sa = *(const f32x4*)sp; r.sb = *(const f32x4*)(sp + 4); return r;
}
DI void rot_apply(const RotIn& r, float (&o1)[8], float (&o2)[8]) {
    float x1[8], x2[8]; unpack8(r.a, x1); unpack8(r.b, x2);
#pragma unroll
    for (int e = 0; e < 8; ++e) { const float c = e < 4 ? r.ca[e & 3] : r.cb[e & 3], s = e < 4 ? r.sa[e & 3] : r.sb[e & 3]; o1[e] = x1[e] * c - x2[e] * s; o2[e] = x1[e] * s + x2[e] * c; }
}
DI void stage_rot_rm_b(LAS unsigned char* dst, const bf16_t* src, const float* rtc, const float* rts, int pos0, float scale, int tid) {
    const RotIn r0 = rot_load(src, rtc, rts, pos0, tid >> 3, (tid & 7) * 8), r1 = rot_load(src, rtc, rts, pos0, 64 + (tid >> 3), (tid & 7) * 8);
#pragma unroll
    for (int k = 0; k < 2; ++k) { const int j = 64 * k + (tid >> 3), d0 = (tid & 7) * 8; float o1[8], o2[8]; rot_apply(k ? r1 : r0, o1, o2);
        u32x4 w1, w2; w1.x = cvt_pk_bf16(o1[0] * scale, o1[1] * scale); w1.y = cvt_pk_bf16(o1[2] * scale, o1[3] * scale); w1.z = cvt_pk_bf16(o1[4] * scale, o1[5] * scale); w1.w = cvt_pk_bf16(o1[6] * scale, o1[7] * scale);
        w2.x = cvt_pk_bf16(o2[0] * scale, o2[1] * scale); w2.y = cvt_pk_bf16(o2[2] * scale, o2[3] * scale); w2.z = cvt_pk_bf16(o2[4] * scale, o2[5] * scale); w2.w = cvt_pk_bf16(o2[6] * scale, o2[7] * scale);
        *(LAS u32x4*)(dst + sw(j, d0) * 2) = w1; *(LAS u32x4*)(dst + sw(j, 64 + d0) * 2) = w2; }
}
DI void stage_rot_T2_b(LAS unsigned char* dF, LAS unsigned char* dB, const bf16_t* src, const float* rtc, const float* rts, int pos0, float scale, float lgf, float lgb, int tid) {
    LAS bf16_t* F = (LAS bf16_t*)dF; LAS bf16_t* B = (LAS bf16_t*)dB;
    const RotIn r0 = rot_load(src, rtc, rts, pos0, tid >> 3, (tid & 7) * 8), r1 = rot_load(src, rtc, rts, pos0, 64 + (tid >> 3), (tid & 7) * 8);
#pragma unroll
    for (int k = 0; k < 2; ++k) { const int j = 64 * k + (tid >> 3), d0 = (tid & 7) * 8; float o1[8], o2[8]; rot_apply(k ? r1 : r0, o1, o2);
        const float wf = __expf((float)(127 - j) * lgf) * scale, wb = __expf((float)j * lgb) * scale;
#pragma unroll
        for (int e = 0; e < 8; ++e) { const int i1 = sw(d0 + e, j), i2 = sw(64 + d0 + e, j); F[i1] = f2bf(o1[e] * wf); F[i2] = f2bf(o2[e] * wf); B[i1] = f2bf(o1[e] * wb); B[i2] = f2bf(o2[e] * wb); } }
}
DI void stage_T(LAS unsigned char* dst, const bf16_t* src, int tid) {
    LAS bf16_t* T = (LAS bf16_t*)dst;
    for (int it = tid; it < 2048; it += 512) { const int j = it >> 4, c0 = (it & 15) * 8; const u32x4 w = *(const u32x4*)(src + (size_t)j * PC + c0);
        T[sw(c0 + 0, j)] = (bf16_t)(w.x & 0xffff); T[sw(c0 + 1, j)] = (bf16_t)(w.x >> 16); T[sw(c0 + 2, j)] = (bf16_t)(w.y & 0xffff); T[sw(c0 + 3, j)] = (bf16_t)(w.y >> 16);
        T[sw(c0 + 4, j)] = (bf16_t)(w.z & 0xffff); T[sw(c0 + 5, j)] = (bf16_t)(w.z >> 16); T[sw(c0 + 6, j)] = (bf16_t)(w.w & 0xffff); T[sw(c0 + 7, j)] = (bf16_t)(w.w >> 16); }
}
DI void stage_T_b(LAS unsigned char* dst, const bf16_t* src, int tid) {
    LAS bf16_t* T = (LAS bf16_t*)dst;
    u32x4 wv[4];
#pragma unroll
    for (int k = 0; k < 4; ++k) { const int it = tid + 512 * k, j = it >> 4, c0 = (it & 15) * 8; wv[k] = *(const u32x4*)(src + (size_t)j * PC + c0); }
#pragma unroll
    for (int k = 0; k < 4; ++k) { const int it = tid + 512 * k, j = it >> 4, c0 = (it & 15) * 8; const u32x4 w = wv[k];
        T[sw(c0 + 0, j)] = (bf16_t)(w.x & 0xffff); T[sw(c0 + 1, j)] = (bf16_t)(w.x >> 16); T[sw(c0 + 2, j)] = (bf16_t)(w.y & 0xffff); T[sw(c0 + 3, j)] = (bf16_t)(w.y >> 16);
        T[sw(c0 + 4, j)] = (bf16_t)(w.z & 0xffff); T[sw(c0 + 5, j)] = (bf16_t)(w.z >> 16); T[sw(c0 + 6, j)] = (bf16_t)(w.w & 0xffff); T[sw(c0 + 7, j)] = (bf16_t)(w.w >> 16); }
}
DI void stage_state(LAS unsigned char* dst, const bf16_t* src, int tid) {
    u32x4 wv[4];
#pragma unroll
    for (int k = 0; k < 4; ++k) { const int it = tid + 512 * k, e = it >> 4, d0 = (it & 15) * 8; wv[k] = *(const u32x4*)(src + e * 128 + d0); }
#pragma unroll
    for (int k = 0; k < 4; ++k) { const int it = tid + 512 * k, e = it >> 4, d0 = (it & 15) * 8; *(LAS u32x4*)(dst + sw(e, d0) * 2) = wv[k]; }
}
DI void mma16(f32x4 (&acc)[8], const LAS unsigned char* At, int arow0, const LAS unsigned char* Bt, int lane) {
    const int l15 = lane & 15, quad = lane >> 4;
#pragma unroll
    for (int ks = 0; ks < 4; ++ks) {
        const bf16x8 a = *(const LAS bf16x8*)(At + sw(arow0 + l15, 32 * ks + 8 * quad) * 2);
#pragma unroll
        for (int cg = 0; cg < 8; ++cg) { const bf16x8 b = *(const LAS bf16x8*)(Bt + sw(16 * cg + l15, 32 * ks + 8 * quad) * 2);
            acc[cg] = __builtin_amdgcn_mfma_f32_16x16x32_bf16(a, b, acc[cg], 0, 0, 0); }
    }
}
DI void zero8(f32x4 (&a)[8]) {
#pragma unroll
    for (int i = 0; i < 8; ++i) a[i] = (f32x4){0.f, 0.f, 0.f, 0.f};
}
DI void kv_unit(const Inputs& in, int l, unsigned char* ws, int half, int u, LAS unsigned char* lds, int tid) {
    asm volatile("" : "+v"(tid));
    const int L = half ? 2048 : 4096, NC = L / 128, h = u & 3, sn = u >> 2, s = sn / NC, n = sn % NC, row0 = s * L + n * 128, pos0 = n * 128;
    const bf16_t* proj = (const bf16_t*)(ws + WS_PROJ); const float* rtc = (const float*)(ws + WS_RTC); const float* rts = (const float*)(ws + WS_RTS);
    bf16_t* KV = (bf16_t*)(ws + WS_KV);
    const float lgf = logsig(in.ret_decay[l * 8 + h]), lgb = logsig(in.ret_decay[l * 8 + 4 + h]);
    LAS unsigned char* VTt = lds; LAS unsigned char* KfT = lds + TILE_B; LAS unsigned char* KbT = lds + 2 * TILE_B;
    stage_T_b(VTt, proj + (size_t)row0 * PC + C_RV + 128 * h, tid);
    stage_rot_T2_b(KfT, KbT, proj + (size_t)row0 * PC + C_RK + 128 * h, rtc, rts, pos0, 0.088388347648318440f, lgf, lgb, tid);
    __syncthreads();
    const int wave = tid >> 6, lane = tid & 63, l15 = lane & 15, quad = lane >> 4;
    f32x4 af[8], ab[8]; zero8(af); zero8(ab);
    mma16(af, KfT, 16 * wave, VTt, lane); mma16(ab, KbT, 16 * wave, VTt, lane);
    bf16_t* of = KV + (size_t)(u * 2 + 0) * 16384; bf16_t* ob = KV + (size_t)(u * 2 + 1) * 16384;
#pragma unroll
    for (int cg = 0; cg < 8; ++cg) { const int e = 16 * cg + l15, d = 16 * wave + 4 * quad;
        u32x2 wf, wb2; wf.x = cvt_pk_bf16(af[cg][0], af[cg][1]); wf.y = cvt_pk_bf16(af[cg][2], af[cg][3]); wb2.x = cvt_pk_bf16(ab[cg][0], ab[cg][1]); wb2.y = cvt_pk_bf16(ab[cg][2], ab[cg][3]);
        *(u32x2*)(of + e * 128 + d) = wf; *(u32x2*)(ob + e * 128 + d) = wb2; }
    __syncthreads();
}
DI void scan(const Inputs& in, int l, unsigned char* ws, int half, int gtid, int NT) {
    const int L = half ? 2048 : 4096, NC = L / 128, NB = half ? 8 : 4;
    const bf16_t* KV = (const bf16_t*)(ws + WS_KV); bf16_t* SS = (bf16_t*)(ws + WS_KV + 32 * MiB);
    for (int idx = gtid; idx < NB * 32768; idx += NT) {
        const int elem = (idx & 4095) * 4, dir = (idx >> 12) & 1, h = (idx >> 13) & 3, s = idx >> 15;
        const float decay = __expf(128.f * logsig(in.ret_decay[l * 8 + dir * 4 + h]));
        const size_t base = ((size_t)(s * NC * 4 + h) * 2 + dir) * 16384 + elem;
        u32x2 v[32];
#pragma unroll
        for (int st = 0; st < 32; ++st) { const int n = dir ? NC - 1 - st : st; v[st] = st < NC ? *(const u32x2*)(KV + base + (size_t)n * 8 * 16384) : (u32x2){0u, 0u}; }
        float S0 = 0.f, S1 = 0.f, S2 = 0.f, S3 = 0.f;
#pragma unroll
        for (int st = 0; st < 32; ++st) { const int n = dir ? NC - 1 - st : st;
            if (st < NC) { u32x2 o; o.x = cvt_pk_bf16(S0, S1); o.y = cvt_pk_bf16(S2, S3); *(u32x2*)(SS + base + (size_t)n * 8 * 16384) = o;
                S0 = S0 * decay + bflo(v[st].x); S1 = S1 * decay + bfhi(v[st].x); S2 = S2 * decay + bflo(v[st].y); S3 = S3 * decay + bfhi(v[st].y); } }
    }
}
DI void out_unit(const Inputs& in, int l, unsigned char* ws, int half, int u, LAS unsigned char* lds, int tid) {
    asm volatile("" : "+v"(tid));
    const int L = half ? 2048 : 4096, NC = L / 128, h = u & 3, sn = u >> 2, s = sn / NC, n = sn % NC, row0 = s * L + n * 128, pos0 = n * 128;
    bf16_t* proj = (bf16_t*)(ws + WS_PROJ); const float* rtc = (const float*)(ws + WS_RTC); const float* rts = (const float*)(ws + WS_RTS);
    const bf16_t* SS = (const bf16_t*)(ws + WS_KV + 32 * MiB);
    const float lgf = logsig(in.ret_decay[l * 8 + h]), lgb = logsig(in.ret_decay[l * 8 + 4 + h]);
    const int wave = tid >> 6, lane = tid & 63, l15 = lane & 15, quad = lane >> 4;
    LAS unsigned char* Qt = lds; LAS unsigned char* Kt = lds + TILE_B; LAS unsigned char* VTt = lds + 2 * TILE_B; LAS unsigned char* Ps = lds + 3 * TILE_B + wave * (16 * TS * 2);
    stage_rot_rm_b(Qt, proj + (size_t)row0 * PC + C_RQ + 128 * h, rtc, rts, pos0, 1.0f, tid);
    stage_rot_rm_b(Kt, proj + (size_t)row0 * PC + C_RK + 128 * h, rtc, rts, pos0, 0.088388347648318440f, tid);
    stage_T_b(VTt, proj + (size_t)row0 * PC + C_RV + 128 * h, tid);
    __syncthreads();
    f32x4 O[8], F[8];
    zero8(F); mma16(F, Qt, 16 * wave, Kt, lane);
#pragma unroll
    for (int cg = 0; cg < 8; ++cg)
#pragma unroll
        for (int r = 0; r < 4; ++r) { const int i = 16 * wave + 4 * quad + r, j = 16 * cg + l15, df = i - j;
            const float fac = df >= 0 ? __expf((float)df * lgf) : __expf((float)(-df) * lgb);
            ((LAS bf16_t*)Ps)[sw(4 * quad + r, j)] = f2bf(F[cg][r] * fac); }
    LDS_WAIT();
    zero8(O); mma16(O, Ps, 0, VTt, lane);
    __syncthreads();
    stage_state(Kt, SS + (size_t)(u * 2 + 0) * 16384, tid); stage_state(VTt, SS + (size_t)(u * 2 + 1) * 16384, tid);
    __syncthreads();
    zero8(F); mma16(F, Qt, 16 * wave, Kt, lane);
#pragma unroll
    for (int r = 0; r < 4; ++r) { const int i = 16 * wave + 4 * quad + r; const float qwf = __expf((float)(i + 1) * lgf);
#pragma unroll
        for (int cg = 0; cg < 8; ++cg) O[cg][r] += qwf * F[cg][r]; }
    zero8(F); mma16(F, Qt, 16 * wave, VTt, lane);
    LAS bf16_t* Pn = (LAS bf16_t*)Ps;
#pragma unroll
    for (int r = 0; r < 4; ++r) { const int i = 16 * wave + 4 * quad + r; const float qwb = __expf((float)(128 - i) * lgb);
        float sm = 0.f;
#pragma unroll
        for (int cg = 0; cg < 8; ++cg) { O[cg][r] += qwb * F[cg][r]; sm += O[cg][r]; }
        sm += __shfl_xor(sm, 1); sm += __shfl_xor(sm, 2); sm += __shfl_xor(sm, 4); sm += __shfl_xor(sm, 8);
        const float mean = sm * (1.f / 128.f); float vs = 0.f;
#pragma unroll
        for (int cg = 0; cg < 8; ++cg) { const float dd = O[cg][r] - mean; vs += dd * dd; }
        vs += __shfl_xor(vs, 1); vs += __shfl_xor(vs, 2); vs += __shfl_xor(vs, 4); vs += __shfl_xor(vs, 8);
        const float rinv = __builtin_amdgcn_rsqf(vs * (1.f / 128.f) + EPS);
#pragma unroll
        for (int cg = 0; cg < 8; ++cg) Pn[(4 * quad + r) * TS + 16 * cg + l15] = f2bf((O[cg][r] - mean) * rinv);
    }
    LDS_WAIT();
    { const int rr = lane >> 2, part = lane & 3; bf16_t* rowp = proj + (size_t)(row0 + 16 * wave + rr) * PC + 128 * h + 32 * part;
      u32x4 gv[4];
#pragma unroll
      for (int q = 0; q < 4; ++q) gv[q] = *(const u32x4*)(rowp + C_RG + 8 * q);
#pragma unroll
      for (int q = 0; q < 4; ++q) { float g[8], o[8]; unpack8(gv[q], g); unpack8(*(const LAS u32x4*)(Pn + rr * TS + 32 * part + 8 * q), o);
#pragma unroll
          for (int e = 0; e < 8; ++e) o[e] = g[e] * sigmoidf_(g[e]) * o[e];
          u32x4 w; w.x = cvt_pk_bf16(o[0], o[1]); w.y = cvt_pk_bf16(o[2], o[3]); w.z = cvt_pk_bf16(o[4], o[5]); w.w = cvt_pk_bf16(o[6], o[7]);
          *(u32x4*)(rowp + C_RQ + 8 * q) = w; } }
    __syncthreads();
}
}


#define XB_TMO      128
#define XB_XCNT(j)  (256  + 64 * (j))
#define XB_XSUB(j)  (1280 + 64 * (j))
#define XB_XGEN(j)  (2304 + 64 * (j))
#define XB_TOP      3328
#define XB_TOPGEN   3392
#define XCD_BAR_WORDS 3456
#define XB_SPIN_CAP (1u << 22)
DI unsigned xb_ld(unsigned* p)              { return __hip_atomic_load(p, __ATOMIC_RELAXED, __HIP_MEMORY_SCOPE_AGENT); }
DI unsigned xb_add(unsigned* p, unsigned v) { return __hip_atomic_fetch_add(p, v, __ATOMIC_RELAXED, __HIP_MEMORY_SCOPE_AGENT); }
DI unsigned xb_xcc_id() { return (unsigned)__builtin_amdgcn_s_getreg((3 << 11) | 20) & 0xFu; }
#define XB_SPIN(cond, bar) do { unsigned _sp = 0; while (cond) { __builtin_amdgcn_s_sleep(1); \
    if ((++_sp & 255u) == 0u) { if (xb_ld(&(bar)[XB_TMO])) break; if (_sp > XB_SPIN_CAP) { atomicAdd(&(bar)[XB_TMO], 1u); break; } } } } while (0)
DI void xcd_barrier_complete(unsigned* bar, unsigned x, unsigned G, unsigned& nloc, unsigned& nx) {
    unsigned sum, cnt, mine, sp = 0u;
    for (;;) {
        sum = 0u; cnt = 0u; mine = 0u;
#pragma unroll
        for (unsigned j = 0; j < 16; ++j) { const unsigned c = xb_ld(&bar[XB_XCNT(j)]); sum += c; cnt += (c > 0u) ? 1u : 0u; mine = (j == x) ? c : mine; }
        if (sum == G) break;
        __builtin_amdgcn_s_sleep(1);
        if ((++sp & 255u) == 0u) { if (xb_ld(&bar[XB_TMO])) break; if (sp > XB_SPIN_CAP) { atomicAdd(&bar[XB_TMO], 1u); break; } }
    }
    nloc = mine > 0u ? mine : 1u; nx = cnt > 0u ? cnt : 1u;
}
DI void xcd_barrier(unsigned* bar, volatile LAS unsigned* st, bool leader, unsigned G) {
    asm volatile("s_waitcnt vmcnt(0)" ::: "memory");
    __syncthreads();
    if (leader) {
        const unsigned x = xb_xcc_id();
        __builtin_amdgcn_s_waitcnt(0);
        unsigned nloc = st[0], nx = st[1];
        if (nloc == 0u) { xcd_barrier_complete(bar, x, G, nloc, nx); st[0] = nloc; st[1] = nx; }
        const unsigned old = xb_add(&bar[XB_XSUB(x)], 1u);
        const unsigned gen = old / nloc;
        if (old + 1u == (gen + 1u) * nloc) {
            __builtin_amdgcn_fence(__ATOMIC_RELEASE, "agent");
            asm volatile("s_waitcnt vmcnt(0)" ::: "memory");
            const unsigned og = xb_add(&bar[XB_TOP], 1u);
            const unsigned tg = og / nx;
            if (og + 1u == (tg + 1u) * nx) xb_add(&bar[XB_TOPGEN], 1u);
            else XB_SPIN(xb_ld(&bar[XB_TOPGEN]) == tg, bar);
            __builtin_amdgcn_fence(__ATOMIC_ACQUIRE, "agent");
            xb_add(&bar[XB_XGEN(x)], 1u);
            asm volatile("s_waitcnt vmcnt(0)" ::: "memory");
        } else {
            XB_SPIN(xb_ld(&bar[XB_XGEN(x)]) == gen, bar);
            __builtin_amdgcn_fence(__ATOMIC_ACQUIRE, "agent");
            asm volatile("s_waitcnt vmcnt(0)" ::: "memory");
        }
    }
    __syncthreads();
}

struct SchedGrid { const char* A; const char* B; int nM, nN, G, c; size_t astep, bstep;
    DI bool next(int i, Unit& u) const { const int L = i * G + c; if (L >= nM * nN) return false; int pm, pn; pg8::tile_order(nM, nN, L, pm, pn);
        u.A = A + (size_t)pm * astep; u.B = B + (size_t)pn * bstep; u.pm = pm; u.pn = pn; u.z = 0; return true; } };
struct SchedA1 { const char* XN; const char* Win; const char* MN; const char* Wkv; int G, c, extra;
    DI bool next(int i, Unit& u) const { int L = i * G + c;
        if (L < 1920) { int pm, pn; pg8::tile_order(64, 30, L, pm, pn); u.A = XN + (size_t)pm * 256 * 1024 * 2; u.B = Win + (size_t)pn * 256 * 1024 * 2; u.pm = pm; u.pn = pn; u.z = 0; return true; }
        if (!extra) return false;
        L -= 1920;
        if (L < 48) { const int pm = L >> 2, pn = L & 3; u.A = MN + (size_t)pm * 256 * 1024 * 2; u.B = Wkv + (size_t)pn * 256 * 1024 * 2; u.pm = pm; u.pn = pn; u.z = 1; return true; }
        L -= 48;
        if (L < 48) { const int bm = L >> 2, pm = L & 3; u.A = Wkv + (size_t)(1024 + pm * 256) * 1024 * 2; u.B = MN + (size_t)bm * 256 * 1024 * 2; u.pm = pm; u.pn = 0; u.z = 2 + bm; return true; }
        return false; } };
struct FA1 { bf16_t *O, *KK, *VVT;
    DI void operator()(const Unit& u, int r, int c, f32x4 a, f32x4 b) const {
        if (u.z == 0) { const int col = u.pn * 256 + c;
            if (col >= C_G) {
                unsigned q[8];
#pragma unroll
                for (int e = 0; e < 4; ++e) { q[e] = (unsigned)(sigmoidf_(a[e]) * 255.f + 0.5f); q[4 + e] = (unsigned)(sigmoidf_(b[e]) * 255.f + 0.5f); }
                u32x2 w; w.x = q[0] | (q[1] << 8) | (q[2] << 16) | (q[3] << 24); w.y = q[4] | (q[5] << 8) | (q[6] << 16) | (q[7] << 24);
                __builtin_nontemporal_store(w, (u32x2*)((unsigned char*)(O + (size_t)(u.pm * 256 + r) * PC + C_G) + (col - C_G))); }
            else *(u32x4*)(O + (size_t)(u.pm * 256 + r) * PC + col) = pack8(a, b); }
        else if (u.z == 1) *(u32x4*)(KK + (size_t)(u.pm * 256 + r) * 1024 + u.pn * 256 + c) = pack8(a, b);
        else *(u32x4*)(VVT + ((size_t)(u.z - 2) * 1024 + u.pm * 256 + r) * 256 + c) = pack8(a, b); } };
struct SchedBranch { const char* proj; const char* W; int G, c;
    DI bool next(int i, Unit& u) const { const int mac = (i / 3) * G + c, br = i % 3; if (mac >= 256) return false; int pm, pn; pg8::tile_order(64, 4, mac, pm, pn);
        const int acol = br == 0 ? C_YH : (br == 1 ? C_RQ : C_AQ);
        u.A = proj + ((size_t)pm * 256 * PC + acol) * 2; u.B = W + ((size_t)br * 1024 * 512 + (size_t)pn * 256 * 512) * 2; u.pm = pm; u.pn = pn; u.z = br; return true; } };
struct SchedX1 { const char* XN; const char* MN; const char* Wq; const char* Wkv; int G, c;
    DI bool next(int i, Unit& u) const { int L = i * G + c;
        if (L < 512) { int pm, pn; pg8::tile_order(128, 4, L, pm, pn); u.A = XN + (size_t)pm * 256 * 1024 * 2; u.B = Wq + (size_t)pn * 256 * 1024 * 2; u.pm = pm; u.pn = pn; u.z = 0; return true; }
        L -= 512;
        if (L < 48) { const int pm = L >> 2, pn = L & 3; u.A = MN + (size_t)pm * 256 * 1024 * 2; u.B = Wkv + (size_t)pn * 256 * 1024 * 2; u.pm = pm; u.pn = pn; u.z = 1; return true; }
        L -= 48;
        if (L < 48) { const int bm = L >> 2, pm = L & 3; u.A = Wkv + (size_t)(1024 + pm * 256) * 1024 * 2; u.B = MN + (size_t)bm * 256 * 1024 * 2; u.pm = pm; u.pn = 0; u.z = 2 + bm; return true; }
        return false; } };
DI int mem_batch(int row0) { return row0 < 16384 ? (row0 >> 12) : 4 + ((row0 - 16384) >> 11); }
struct SchedX2 { const char* QX; const char* KK; int G, c;
    DI bool next(int i, Unit& u) const { const int L = i * G + c; if (L >= 512) return false; const int pm = L >> 2, h = L & 3, bm = mem_batch(pm * 256);
        u.A = QX + ((size_t)pm * 256 * 1024 + 256 * h) * 2; u.B = KK + ((size_t)bm * 256 * 1024 + 256 * h) * 2; u.pm = pm; u.pn = h; u.z = h; return true; } };
struct SchedX3 { const char* P; const char* VVT; int G, c;
    DI bool next(int i, Unit& u) const { const int L = i * G + c; if (L >= 512) return false; const int pm = L >> 2, h = L & 3, bm = mem_batch(pm * 256);
        u.A = P + ((size_t)pm * 256 * 1024 + 256 * h) * 2; u.B = VVT + ((size_t)(bm * 1024 + 256 * h) * 256) * 2; u.pm = pm; u.pn = h; u.z = h; return true; } };

struct FProj { bf16_t* O;
    DI void operator()(const Unit& u, int r, int c, f32x4 a, f32x4 b) const { const int col = u.pn * 256 + c;
        if (col >= C_G) {
#pragma unroll
            for (int e = 0; e < 4; ++e) { a[e] = sigmoidf_(a[e]); b[e] = sigmoidf_(b[e]); } }
        *(u32x4*)(O + (size_t)(u.pm * 256 + r) * PC + col) = pack8(a, b); } };
template <int ACT> struct FStore { bf16_t* O; int ldc; float sc;
    DI void operator()(const Unit& u, int r, int c, f32x4 a, f32x4 b) const {
        if (ACT == 1) {
#pragma unroll
            for (int e = 0; e < 4; ++e) { const float x = fmaxf(a[e], 0.f), y = fmaxf(b[e], 0.f); a[e] = x * x; b[e] = y * y; } }
        *(u32x4*)(O + (size_t)(u.pm * 256 + r) * ldc + u.pn * 256 + c) = pack8(a * sc, b * sc); } };
struct EpiBranch { const bf16_t* proj; bf16_t* M;
    DI void operator()(f32x4 (&acc)[2][2][4][2], const Unit& u, int wr, int wc, int fr, int fq, LAS unsigned char*) const {
        asm volatile("" : "+v"(fr), "+v"(fq));
#pragma unroll
        for (int ai = 0; ai < 2; ++ai) {
            u32x2 gv[4][2]; u32x4 pv[4][2];
#pragma unroll
            for (int m = 0; m < 4; ++m)
#pragma unroll
                for (int bj = 0; bj < 2; ++bj) { const int row = u.pm * 256 + ai * 128 + wr * 64 + m * 16 + fr, col = u.pn * 256 + bj * 128 + wc * 32 + 8 * fq;
                    gv[m][bj] = *(const u32x2*)((const unsigned char*)(proj + (size_t)row * PC + C_G) + u.z * 1024 + col);
                    pv[m][bj] = (u32x4){0u, 0u, 0u, 0u}; if (u.z) pv[m][bj] = *(const u32x4*)(M + (size_t)row * 1024 + col); }
#pragma unroll
            for (int m = 0; m < 4; ++m)
#pragma unroll
                for (int bj = 0; bj < 2; ++bj) { const int row = u.pm * 256 + ai * 128 + wr * 64 + m * 16 + fr, col = u.pn * 256 + bj * 128 + wc * 32 + 8 * fq;
                    float g[8], p[8]; unpack8g(pv[m][bj], p);
#pragma unroll
                    for (int e = 0; e < 4; ++e) { g[e] = (float)((gv[m][bj].x >> (8 * e)) & 0xffu) * (1.f / 255.f); g[4 + e] = (float)((gv[m][bj].y >> (8 * e)) & 0xffu) * (1.f / 255.f); }
                    f32x4 a = acc[ai][bj][m][0], b = acc[ai][bj][m][1];
#pragma unroll
                    for (int e = 0; e < 4; ++e) { a[e] = a[e] * g[e] + p[e]; b[e] = b[e] * g[4 + e] + p[4 + e]; }
                    *(u32x4*)(M + (size_t)row * 1024 + col) = pack8(a, b); }
        }
    } };
struct FX1 { bf16_t *QX, *KK, *VVT;
    DI void operator()(const Unit& u, int r, int c, f32x4 a, f32x4 b) const {
        if (u.z == 0) *(u32x4*)(QX + (size_t)(u.pm * 256 + r) * 1024 + u.pn * 256 + c) = pack8(a * 0.0625f, b * 0.0625f);
        else if (u.z == 1) *(u32x4*)(KK + (size_t)(u.pm * 256 + r) * 1024 + u.pn * 256 + c) = pack8(a, b);
        else *(u32x4*)(VVT + ((size_t)(u.z - 2) * 1024 + u.pm * 256 + r) * 256 + c) = pack8(a, b); } };

__global__ void __launch_bounds__(512, 2) mega(Args args) {
    extern __shared__ __attribute__((aligned(16))) unsigned char lds_g[];
    cg::grid_group grid = cg::this_grid();
    LAS unsigned char* lds = (LAS unsigned char*)lds_g;
    LAS unsigned char* lx = lds + LDS_X;
    const int G0 = gridDim.x, bx0 = blockIdx.x, wave0 = __builtin_amdgcn_readfirstlane(threadIdx.x >> 6);
    const int vcu0 = (G0 % 8 == 0) ? (bx0 % 8) * (G0 / 8) + bx0 / 8 : bx0;
    const int lo = args.ph_lo, hi = args.ph_hi; int ph = 0;
    { const int t0 = opaque_tid(wave0);
      if (t0 < 2) ((volatile LAS unsigned*)(lds + LDS_ST))[t0] = 0u;
      __syncthreads();
      if (t0 == 0) (void)xb_add(&((unsigned*)args.ws)[XB_XCNT(xb_xcc_id())], 1u); }
    typedef const __attribute__((address_space(4))) Args* KArgsP;
#if defined(__HIP_DEVICE_COMPILE__)
#define LOAD_ARGS(p) (*(p))
#else
#define LOAD_ARGS(p) (args)
#endif
#define PH_BEGIN if (ph >= lo && ph < hi) { KArgsP kp_ = (KArgsP)__builtin_amdgcn_kernarg_segment_ptr(); asm volatile("" : "+s"(kp_)); const Args A_ = LOAD_ARGS(kp_); \
        const Inputs& in = A_.in; unsigned char* ws = A_.ws; float* xo = A_.out; (void)in; (void)xo; \
        int G = G0, bx = bx0, vcu = vcu0, wave = wave0; asm volatile("" : "+s"(G), "+s"(bx), "+s"(vcu), "+s"(wave)); \
        const int tid = opaque_tid(wave), lane = tid & 63, gtid = bx * 512 + tid, gw = vcu * 8 + wave, NGW = G * 8, NT = G * 512; (void)lane; (void)gtid; (void)gw; (void)NGW; (void)NT; \
        const char* wb = (const char*)(ws + WS_WB); bf16_t* XN = (bf16_t*)xo; bf16_t* XB = (bf16_t*)(ws + WS_XN); (void)XB; \
        bf16_t* MNb = XN + (size_t)TT * D; bf16_t* KKb = MNb + (size_t)3072 * D; bf16_t* VVTb = KKb + (size_t)3072 * D; (void)MNb; (void)KKb; (void)VVTb;     bf16_t* R = (bf16_t*)(ws + WS_R); bf16_t* proj = (bf16_t*)(ws + WS_PROJ); (void)wb; (void)XN; (void)R; (void)proj;
#define PH_END } ++ph; if (ph > lo && ph < hi) { if (ph == 1) grid.sync(); else { KArgsP kq_ = (KArgsP)__builtin_amdgcn_kernarg_segment_ptr(); asm volatile("" : "+s"(kq_)); \
        xcd_barrier((unsigned*)LOAD_ARGS(kq_).ws, (volatile LAS unsigned*)(lds + LDS_ST), opaque_tid(wave0) == 0, (unsigned)G0); } }

    PH_BEGIN
        make_tables(ws, gtid, NT);
        convert_weights(in, 0, ws, lds, gw, NGW, wave, lane);
        filter_gen(in, 0, ws, lds, vcu, G, wave, tid);
        for (int m0 = gw; m0 < TT; m0 += 4 * NGW) {
            f32x4 v[4][4];
#pragma unroll
            for (int q = 0; q < 4; ++q) { const int m = m0 + q * NGW; const float* xi = m < HT ? in.x_prompt + (size_t)m * D : in.x_sample + (size_t)(m - HT) * D;
#pragma unroll
                for (int j = 0; j < 4; ++j) v[q][j] = __builtin_nontemporal_load((const f32x4*)(xi + 4 * lane + 256 * j)); }
            float ss[4];
#pragma unroll
            for (int q = 0; q < 4; ++q) { ss[q] = 0.f; const size_t m = (size_t)m0 + q * NGW;
#pragma unroll
                for (int j = 0; j < 4; ++j) { u32x2 w; w.x = cvt_pk_bf16(v[q][j][0], v[q][j][1]); w.y = cvt_pk_bf16(v[q][j][2], v[q][j][3]); *(u32x2*)(XB + m * D + 4 * lane + 256 * j) = w;
                    v[q][j] = (f32x4){bflo(w.x), bfhi(w.x), bflo(w.y), bfhi(w.y)};
                    ss[q] += (v[q][j][0] * v[q][j][0] + v[q][j][1] * v[q][j][1]) + (v[q][j][2] * v[q][j][2] + v[q][j][3] * v[q][j][3]); } }
#pragma unroll
            for (int o = 1; o < 64; o <<= 1)
#pragma unroll
                for (int q = 0; q < 4; ++q) ss[q] += __shfl_xor(ss[q], o);
#pragma unroll
            for (int q = 0; q < 4; ++q) { const float rinv = __builtin_amdgcn_rsqf(ss[q] * (1.f / 1024.f) + EPS); const size_t m = (size_t)m0 + q * NGW;
#pragma unroll
                for (int j = 0; j < 4; ++j) { const f32x4 g = *(const f32x4*)(in.g_mix_pre + 4 * lane + 256 * j); const f32x4 o = v[q][j] * rinv * g;
                    u32x2 w; w.x = cvt_pk_bf16(o[0], o[1]); w.y = cvt_pk_bf16(o[2], o[3]); *(u32x2*)(XN + m * D + 4 * lane + 256 * j) = w; } }
        }
    PH_END

    for (int l = 0; l < DEPTH; ++l) {
        for (int half = 0; half < 2; ++half) {
            const int L = half ? 2048 : 4096;
            PH_BEGIN
                SchedA1 S{(const char*)(XN + (size_t)half * HT * D), wb + WB_IN, (const char*)MNb, wb + WB_XKV, G, bx, half};
                pg8::EpiRows<FA1> E{FA1{proj, KKb, VVTb}};
                pg8::gemm_phase(wave, lds, lx, GemmP{1024, 1024, 1024}, S, E);
            PH_END
            PH_BEGIN
                prep_attn(in, l, ws, half, gw, NGW, lane);
                prep_hyena(in, l, ws, half, vcu, G, tid);
                for (int u = vcu; u < 512; u += G) ret::kv_unit(in, l, ws, half, u, lds, tid);
            PH_END
            PH_BEGIN
                ret::scan(in, l, ws, half, gtid, NT);
                const int nqb = L / 256;
                for (int u = vcu; u < 256; u += G) { const int qb = u % nqb, sh = u / nqb, g2 = sh & 1, kvh = (sh >> 1) & 1, s = sh >> 2, h = 2 * kvh + g2;
                    bf16_t* Qb = proj + (size_t)(s * L + qb * 256) * PC + C_AQ + 128 * h;
                    const bf16_t* Kh = proj + (size_t)(s * L) * PC + C_AK + 128 * kvh; const bf16_t* Vh = proj + (size_t)(s * L) * PC + C_AV + 128 * kvh;
                    attn::attn_dense_body(wave, Qb, Kh, Vh, Qb, L, (char*)lds_g); }
                for (int c = vcu; c < 512; c += G) hyena_unit(in, l, ws, half, c, lds, tid);
            PH_END
            PH_BEGIN
                for (int u = vcu; u < 512; u += G) ret::out_unit(in, l, ws, half, u, lds, tid);
                post_hyena(ws, half, lds, vcu, G, tid);
            PH_END
            PH_BEGIN
                SchedBranch S{(const char*)proj, wb + WB_BR, G, bx};
                EpiBranch E{proj, XN + (size_t)half * HT * D};
                pg8::gemm_phase(wave, lds, lx, GemmP{PC, 512, 512}, S, E);
            PH_END
            PH_BEGIN
                SchedGrid S{(const char*)(XN + (size_t)half * HT * D), wb + WB_OUT, 64, 4, G, bx, (size_t)256 * 1024 * 2, (size_t)256 * 1024 * 2};
                pg8::EpiRows<FStore<0>> E{FStore<0>{R + (size_t)half * HT * D, 1024, 1.f}};
                pg8::gemm_phase(wave, lds, lx, GemmP{1024, 1024, 1024}, S, E);
            PH_END
            PH_BEGIN
                for (int m = gw; m < HT; m += 4 * NGW) norm_rows<true, 4>(XB, R, in.g_mix_post + l * D, XB, in.g_x_pre + l * D, XN, (size_t)half * HT + m, (size_t)NGW, lane);
                if (half == 0) for (int m = gw; m < 3072; m += NGW) { const float* mi = m < 1024 ? in.mem_prompt + (size_t)m * D : in.mem_sample + (size_t)(m - 1024) * D;
                    norm_row<false, true>(mi, nullptr, nullptr, nullptr, in.g_mem + l * D, MNb + (size_t)m * D, lane); }
            PH_END
        }
        PH_BEGIN
            SchedGrid S{(const char*)XN, wb + WB_XQ, 128, 4, G, bx, (size_t)256 * 1024 * 2, (size_t)256 * 1024 * 2};
            pg8::EpiRows<FStore<0>> E{FStore<0>{(bf16_t*)(ws + WS_QX), 1024, 0.0625f}};
            pg8::gemm_phase(wave, lds, lx, GemmP{1024, 1024, 1024}, S, E);
        PH_END
        PH_BEGIN
            SchedX2 S{(const char*)(ws + WS_QX), (const char*)KKb, G, bx};
            pg8::EpiSoftmax E{(bf16_t*)(ws + WS_P), 1024};
            pg8::gemm_phase(wave, lds, lx, GemmP{1024, 1024, 256}, S, E);
        PH_END
        PH_BEGIN
            SchedX3 S{(const char*)(ws + WS_P), (const char*)VVTb, G, bx};
            pg8::EpiRows<FStore<0>> E{FStore<0>{(bf16_t*)(ws + WS_OX), 1024, 1.f}};
            pg8::gemm_phase(wave, lds, lx, GemmP{1024, 256, 256}, S, E);
        PH_END
        PH_BEGIN
            SchedGrid S{(const char*)(ws + WS_OX), wb + WB_XO, 128, 4, G, bx, (size_t)256 * 1024 * 2, (size_t)256 * 1024 * 2};
            pg8::EpiRows<FStore<0>> E{FStore<0>{R, 1024, 1.f}};
            pg8::gemm_phase(wave, lds, lx, GemmP{1024, 1024, 1024}, S, E);
        PH_END
        PH_BEGIN
            for (int m = gw; m < TT; m += 4 * NGW) norm_rows<true, 4>(XB, R, in.g_x_post + l * D, XB, in.g_ff_pre + l * D, XN, (size_t)m, (size_t)NGW, lane);
        PH_END
        PH_BEGIN
            SchedGrid S{(const char*)XN, wb + WB_F1, 128, 16, G, bx, (size_t)256 * 1024 * 2, (size_t)256 * 1024 * 2};
            pg8::EpiRows<FStore<1>> E{FStore<1>{(bf16_t*)(ws + WS_U), 4096, 1.f}};
            pg8::gemm_phase(wave, lds, lx, GemmP{1024, 1024, 1024}, S, E);
        PH_END
        PH_BEGIN
            SchedGrid S{(const char*)(ws + WS_U), wb + WB_F2, 128, 4, G, bx, (size_t)256 * 4096 * 2, (size_t)256 * 4096 * 2};
            pg8::EpiRows<FStore<0>> E{FStore<0>{R, 1024, 1.f}};
            pg8::gemm_phase(wave, lds, lx, GemmP{4096, 4096, 4096}, S, E);
        PH_END
        PH_BEGIN
            const bool more = l + 1 < DEPTH;
            if (more) { for (int m = gw; m < TT; m += 4 * NGW) norm_rows<true, 4>(XB, R, in.g_ff_post + l * D, XB, in.g_mix_pre + (l + 1) * D, XN, (size_t)m, (size_t)NGW, lane); }
            else { for (int m = gw; m < TT; m += 4 * NGW) norm_rows<false, 4>(XB, R, in.g_ff_post + l * D, xo, nullptr, nullptr, (size_t)m, (size_t)NGW, lane); }
            if (more) { convert_weights(in, l + 1, ws, lds, gw, NGW, wave, lane); filter_gen(in, l + 1, ws, lds, vcu, G, wave, tid); }
        PH_END
    }
#undef PH_BEGIN
#undef PH_END
}

extern "C" void kernel_launch(void* const* d_in, const int* in_sizes, int n_in, void* d_out, int out_size, void* d_ws, size_t ws_size, hipStream_t stream) {
    static int grid = 0;
    if (grid == 0) {
        if (n_in != 29 || out_size != TT * D || ws_size < WS_END) { fprintf(stderr, "kernel_launch: unexpected shapes: n_in %d out %d ws %zu (need %zu)\n", n_in, out_size, ws_size, (size_t)WS_END); grid = -1; return; }
        int dev = 0, cus = 0, per_cu = 0;
        hipGetDevice(&dev); hipDeviceGetAttribute(&cus, hipDeviceAttributeMultiprocessorCount, dev);
        if (hipFuncSetAttribute((const void*)mega, hipFuncAttributeMaxDynamicSharedMemorySize, LDS_BYTES) != hipSuccess) { fprintf(stderr, "kernel_launch: hipFuncSetAttribute failed\n"); grid = -1; return; }
        if (hipOccupancyMaxActiveBlocksPerMultiprocessor(&per_cu, (const void*)mega, 512, LDS_BYTES) != hipSuccess || per_cu < 1) { fprintf(stderr, "kernel_launch: occupancy query gave %d\n", per_cu); per_cu = 1; }
        (void)hipGetLastError();
        grid = cus * 1;
    }
    if (grid < 0) return;
    Args a{};
    const float** ip = (const float**)&a.in;
    for (int i = 0; i < 29; ++i) ip[i] = (const float*)d_in[i];
    a.out = (float*)d_out; a.ws = (unsigned char*)d_ws; a.ph_lo = 0; a.ph_hi = 1 << 30;
    (void)hipMemsetAsync(d_ws, 0, 16384, stream);
    void* params[] = {&a};
    const hipError_t e = hipLaunchCooperativeKernel((const void*)mega, dim3(grid), dim3(512), params, LDS_BYTES, stream);
    if (e != hipSuccess) fprintf(stderr, "kernel_launch: cooperative launch failed: %s (grid %d)\n", hipGetErrorString(e), grid);
}
```
